# Optimizing an MI355X kernel written in HIP

```python
import math
import jax
import jax.numpy as jnp
from jax import lax
import numpy as np


D_MODEL = 1024
BATCH = 8
SEQ = 8192
DEPTH = 2

CTX_LEN = 256
GRID_W = 64
RMS_EPS = 1e-6
ATT_HEADS = 4
ATT_DH = 64
ATT_DV = 2 * ATT_DH
ATT_QK_W = ATT_HEADS * 2 * ATT_DH
ATT_V_W = ATT_HEADS * ATT_DV
Q_BLOCK = 128
ROPE_BASE = 10000.0
S5_W = 256
S5_GROUP = 16
S5_GROUPS = S5_W // S5_GROUP
S5_STATE = 64
S5_DT_MIN = 1e-3
S5_DT_MAX = 1e-1
HG_W = 256
HG_HEADS = 4
HG_DH = HG_W // HG_HEADS
HG_CHUNK = 64
HG_EXP_CLIP = 60.0
N_BRANCH = 3
SECTION_WIDTHS = (ATT_QK_W, ATT_QK_W, ATT_V_W, S5_W, HG_W, HG_W, HG_W, HG_W, HG_W, N_BRANCH * D_MODEL)
IN_W = 2 * ATT_QK_W + ATT_V_W + S5_W + 5 * HG_W + N_BRANCH * D_MODEL
N_GROUPS = 4
EXP_PER_GROUP = 8
N_EXPERTS = N_GROUPS * EXP_PER_GROUP
TOP_K = 2
D_EXPERT = 512
MOE_BLOCK = 128

kernel_name = 'hybrid_diffusion_trunk'


def rms_norm(x, g):
    xf = x.astype(jnp.float32)
    y = xf * lax.rsqrt(jnp.mean(xf * xf, axis=-1, keepdims=True) + RMS_EPS)
    return (y * g.astype(jnp.float32)).astype(x.dtype)


def project(h, w, keep):
    outs, off = [], 0
    for width, k in zip(SECTION_WIDTHS, keep):
        outs.append(h @ w[:, off:off + width] if k else None)
        off += width
    return outs


def axial_rope(n_tok):
    rows = n_tok // GRID_W
    r, cl = jnp.meshgrid(jnp.arange(rows, dtype=jnp.float32), jnp.arange(GRID_W, dtype=jnp.float32), indexing='ij')
    n_freq = ATT_DH // 4
    inv = ROPE_BASE ** (-jnp.arange(n_freq, dtype=jnp.float32) / n_freq)
    ang = jnp.concatenate([r.reshape(-1, 1) * inv, cl.reshape(-1, 1) * inv], axis=-1)
    return jnp.cos(ang), jnp.sin(ang)


def apply_rope(t, cos, sin):
    half = ATT_DH // 2
    cs = cos[None, :, None, None, :].astype(t.dtype)
    sn = sin[None, :, None, None, :].astype(t.dtype)
    t1, t2 = t[..., :half], t[..., half:]
    return jnp.concatenate([t1 * cs - t2 * sn, t1 * sn + t2 * cs], axis=-1)


def qk_heads(t, g, rope):
    bsz, n = t.shape[:2]
    t = rms_norm(t.reshape(bsz, n, ATT_HEADS, 2, ATT_DH), g)
    return t if rope is None else apply_rope(t, *rope)


def diff_softmax_attend(q, k, v, lam):
    s = jnp.einsum('bqhmd,bkhmd->bhmqk', q, k, preferred_element_type=jnp.float32) * (ATT_DH ** -0.5)
    p = jax.nn.softmax(s, axis=-1)
    a = p[:, :, 0] - lam * p[:, :, 1]
    return jnp.einsum('bhqk,bkhv->bqhv', a.astype(v.dtype), v)


def diff_attention(q_lat, k_all, v_all, lam):
    bsz, n = q_lat.shape[:2]
    nb = n // Q_BLOCK
    qb = jnp.swapaxes(q_lat.reshape(bsz, nb, Q_BLOCK, ATT_HEADS, 2, ATT_DH), 0, 1)
    ob = lax.map(lambda qq: diff_softmax_attend(qq, k_all, v_all, lam), qb)
    return jnp.swapaxes(ob, 0, 1).reshape(bsz, n, ATT_HEADS, ATT_DV)


def diff_head_out(o, g, lam_init):
    bsz, n = o.shape[:2]
    return (rms_norm(o, g) * (1.0 - lam_init)).reshape(bsz, n, ATT_V_W)


def s5_discretise(a_re, a_im, log_dt, b_re, b_im):
    lam = lax.complex(a_re.astype(jnp.float32), a_im.astype(jnp.float32))
    dt = jnp.exp(log_dt.astype(jnp.float32))[:, None]
    lam_bar = jnp.exp(lam * dt)
    bmat = lax.complex(b_re.astype(jnp.float32), b_im.astype(jnp.float32))
    b_bar = ((lam_bar - 1.0) / lam)[:, :, None] * bmat
    return lam_bar, b_bar


def s5_drive(u, b_bar):
    bsz, n = u.shape[:2]
    ug = u.astype(jnp.float32).reshape(bsz, n, S5_GROUPS, S5_GROUP)
    return lax.complex(jnp.einsum('bngh,gph->bngp', ug, jnp.real(b_bar)),
                       jnp.einsum('bngh,gph->bngp', ug, jnp.imag(b_bar)))


def diag_scan(lam_bar, bu, h0, reverse):
    if h0 is not None:
        edge = bu.shape[1] - 1 if reverse else 0
        bu = bu.at[:, edge].add(lam_bar * h0)
    a = jnp.broadcast_to(lam_bar, (1, bu.shape[1]) + lam_bar.shape)

    def combine(e1, e2):
        a1, b1 = e1
        a2, b2 = e2
        return a1 * a2, a2 * b1 + b2

    _, h = lax.associative_scan(combine, (a, bu), reverse=reverse, axis=1)
    return h


def s5_readout(h, u, c_re, c_im, d, glu_w, glu_b):
    bsz, n = u.shape[:2]
    y = (jnp.einsum('bngp,ghp->bngh', jnp.real(h), c_re.astype(jnp.float32))
         - jnp.einsum('bngp,ghp->bngh', jnp.imag(h), c_im.astype(jnp.float32)))
    y = y.reshape(bsz, n, S5_W) + d.astype(jnp.float32) * u.astype(jnp.float32)
    z = jax.nn.gelu(y)
    z = z * jax.nn.sigmoid(z @ glu_w.astype(jnp.float32) + glu_b.astype(jnp.float32))
    return z.astype(u.dtype)


def hgrn_heads(t):
    return t.astype(jnp.float32).reshape(t.shape[0], t.shape[1], HG_HEADS, HG_DH)


def hgrn_forget(fz, lb):
    fz = hgrn_heads(fz)
    lb = lb.reshape(HG_HEADS, HG_DH)
    log_f = jax.nn.log_sigmoid(fz) + jnp.log1p(lb * jnp.exp(jnp.minimum(-fz, HG_EXP_CLIP)))
    k = (1.0 - lb) * jax.nn.sigmoid(-fz)
    return k, log_f


def hgrn_chunk_scan(q, k, v, log_f, s0):
    bsz, n = q.shape[:2]
    n_chunk = n // HG_CHUNK

    def chunks(t):
        return t.reshape(bsz, n_chunk, HG_CHUNK, HG_HEADS, t.shape[-1]).transpose(1, 0, 3, 2, 4)

    lower_tri = jnp.tril(jnp.ones((HG_CHUNK, HG_CHUNK), dtype=bool))[:, :, None]

    def step(state, inp):
        qc, kc, vc, gc = inp
        b = jnp.cumsum(gc, axis=2)
        o_inter = jnp.einsum('bhtk,bhkv->bhtv', qc * jnp.exp(b), state)
        diff = b[:, :, :, None, :] - b[:, :, None, :, :]
        decay = jnp.where(lower_tri, jnp.exp(jnp.where(lower_tri, diff, 0.0)), 0.0)
        att = jnp.einsum('bhtk,bhsk,bhtsk->bhts', qc, kc, decay)
        o = o_inter + jnp.einsum('bhts,bhsv->bhtv', att, vc)
        b_last = b[:, :, -1:, :]
        new_state = (jnp.exp(b_last[:, :, 0, :, None]) * state
                     + jnp.einsum('bhsk,bhsv->bhkv', kc * jnp.exp(b_last - b), vc))
        return new_state, o

    s_fin, o = lax.scan(step, s0, (chunks(q), chunks(k), chunks(v), chunks(log_f)))
    return o.transpose(1, 0, 3, 2, 4).reshape(bsz, n, HG_HEADS, v.shape[-1]), s_fin


def hgrn_bidir(q, v, kf, gf, kb, gb, s0f, s0b):
    flip = lambda t: t[:, ::-1]
    of, sf = hgrn_chunk_scan(q, kf, v, gf, s0f)
    ob, sb = hgrn_chunk_scan(flip(q), flip(kb), flip(v), flip(gb), s0b)
    return of + flip(ob), sf, sb


def hgrn_readout(o, g, norm_g):
    bsz, n = o.shape[:2]
    y = rms_norm(o, norm_g) * jax.nn.silu(hgrn_heads(g))
    return y.reshape(bsz, n, HG_W).astype(g.dtype)


def merge_branches(y_att, y_s5, y_hg, gate_logits, w_o_att, w_o_s5, w_o_hg, w_out):
    bsz, n = y_att.shape[:2]
    g = jax.nn.sigmoid(gate_logits.reshape(bsz, n, N_BRANCH, D_MODEL))
    m = g[:, :, 0] * (y_att @ w_o_att) + g[:, :, 1] * (y_s5 @ w_o_s5) + g[:, :, 2] * (y_hg @ w_o_hg)
    return m @ w_out


def hier_moe(h, w_group, b_group, w_expert, b_expert, w_gate, w_up, w_down):
    n_tok, dm = h.shape
    lg = (h @ w_group).astype(jnp.float32) + b_group.astype(jnp.float32)
    g_sel = jnp.argmax(lg, axis=-1)
    p_g = jnp.max(jax.nn.softmax(lg, axis=-1), axis=-1)
    le = ((h @ w_expert).astype(jnp.float32) + b_expert.astype(jnp.float32)).reshape(n_tok, N_GROUPS, EXP_PER_GROUP)
    le_sel = jnp.take_along_axis(le, g_sel[:, None, None], axis=1)[:, 0]
    top_p, top_i = lax.top_k(jax.nn.softmax(le_sel, axis=-1), TOP_K)
    wts = p_g[:, None] * top_p / jnp.sum(top_p, axis=-1, keepdims=True)
    eid = (g_sel[:, None] * EXP_PER_GROUP + top_i).astype(jnp.int32)
    n_asg = n_tok * TOP_K
    n_blk = -(-n_asg // MOE_BLOCK) + N_EXPERTS
    cap = n_blk * MOE_BLOCK
    flat_e = eid.reshape(-1)
    flat_w = wts.reshape(-1)
    flat_t = jnp.repeat(jnp.arange(n_tok, dtype=jnp.int32), TOP_K)
    counts = jax.ops.segment_sum(jnp.ones((n_asg,), jnp.int32), flat_e, num_segments=N_EXPERTS)
    padded = (counts + MOE_BLOCK - 1) // MOE_BLOCK * MOE_BLOCK
    pad_end = jnp.cumsum(padded)
    pad_start = pad_end - padded
    cnt_start = jnp.cumsum(counts) - counts
    order = jnp.argsort(flat_e)
    se = flat_e[order]
    dest = pad_start[se] + jnp.arange(n_asg, dtype=jnp.int32) - cnt_start[se]
    buf_tok = jnp.full((cap,), n_tok, jnp.int32).at[dest].set(flat_t[order])
    buf_w = jnp.zeros((cap,), jnp.float32).at[dest].set(flat_w[order])
    blk_e = jnp.minimum(jnp.searchsorted(pad_end, jnp.arange(n_blk, dtype=jnp.int32) * MOE_BLOCK, side='right'),
                        N_EXPERTS - 1)
    hp = jnp.concatenate([h, jnp.zeros((1, dm), h.dtype)], axis=0)
    xb = hp[buf_tok].reshape(n_blk, MOE_BLOCK, dm)

    def expert_block(args):
        xblk, e = args
        return (jax.nn.silu(xblk @ w_gate[e]) * (xblk @ w_up[e])) @ w_down[e]

    yb = lax.map(expert_block, (xb, blk_e)).reshape(cap, dm)
    out = jnp.zeros((n_tok + 1, dm), h.dtype).at[buf_tok].add(yb * buf_w[:, None].astype(h.dtype))
    return out[:n_tok]


def setup_inputs(seed: int = 0) -> dict:
    key = jax.random.key(seed)
    keys = jax.random.split(key, 48)
    counter = [0]

    def nxt():
        k = keys[counter[0]]
        counter[0] += 1
        return k

    def nrm(shape, scale):
        return jax.random.normal(nxt(), shape, jnp.float32) * scale

    def gain(shape):
        return 1.0 + nrm(shape, 0.02)

    L, D = DEPTH, D_MODEL
    G, P, H = S5_GROUPS, S5_STATE, S5_GROUP
    x = nrm((BATCH, SEQ, D), 1.0)
    c = nrm((BATCH, D), 1.0)
    ctx = nrm((BATCH, CTX_LEN, D), 1.0)
    c_ctx = nrm((D,), 1.0)
    ada_w = nrm((L, D, 6 * D), 0.5 * D ** -0.5)
    ada_b = nrm((L, 6 * D), 0.02)
    norm_mix_g = gain((L, D))
    norm_ffn_g = gain((L, D))
    w_in = nrm((L, D, IN_W), D ** -0.5)
    q_norm_g = gain((L, ATT_DH))
    k_norm_g = gain((L, ATT_DH))
    diff_lambda = nrm((L, 4, ATT_DH), 0.1)
    subln_g = gain((L, ATT_DV))
    s5_a_re = -0.5 + nrm((L, 2, G, P), 1e-3)
    s5_a_im = np.pi * jnp.arange(P, dtype=jnp.float32) + nrm((L, 2, G, P), 1e-3)
    s5_log_dt = math.log(S5_DT_MIN) + jax.random.uniform(nxt(), (L, 2, G), jnp.float32) * (
        math.log(S5_DT_MAX) - math.log(S5_DT_MIN))
    s5_b_re = nrm((L, G, P, H), (2.0 * H) ** -0.5)
    s5_b_im = nrm((L, G, P, H), (2.0 * H) ** -0.5)
    s5_c_re = nrm((L, G, H, P), (2.0 * P) ** -0.5)
    s5_c_im = nrm((L, G, H, P), (2.0 * P) ** -0.5)
    s5_d = nrm((L, S5_W), 0.5)
    s5_glu_w = nrm((L, S5_W, S5_W), S5_W ** -0.5)
    s5_glu_b = nrm((L, S5_W), 0.02)
    hg_lb_logits = nrm((L, 2, HG_W), 0.5)
    hg_norm_g = gain((L, HG_DH))
    w_o_att = nrm((L, ATT_V_W, D), ATT_V_W ** -0.5)
    w_o_s5 = nrm((L, S5_W, D), S5_W ** -0.5)
    w_o_hg = nrm((L, HG_W, D), HG_W ** -0.5)
    w_out = nrm((L, D, D), D ** -0.5)
    moe_w_group = nrm((L, D, N_GROUPS), D ** -0.5)
    moe_b_group = nrm((L, N_GROUPS), 0.01)
    moe_w_expert = nrm((L, D, N_EXPERTS), D ** -0.5)
    moe_b_expert = nrm((L, N_EXPERTS), 0.01)
    moe_w_gate = nrm((L, N_EXPERTS, D, D_EXPERT), D ** -0.5)
    moe_w_up = nrm((L, N_EXPERTS, D, D_EXPERT), D ** -0.5)
    moe_w_down = nrm((L, N_EXPERTS, D_EXPERT, D), D_EXPERT ** -0.5)
    return {'x': x, 'c': c, 'ctx': ctx, 'c_ctx': c_ctx, 'ada_w': ada_w, 'ada_b': ada_b,
            'norm_mix_g': norm_mix_g, 'norm_ffn_g': norm_ffn_g, 'w_in': w_in,
            'q_norm_g': q_norm_g, 'k_norm_g': k_norm_g, 'diff_lambda': diff_lambda, 'subln_g': subln_g,
            's5_a_re': s5_a_re, 's5_a_im': s5_a_im, 's5_log_dt': s5_log_dt,
            's5_b_re': s5_b_re, 's5_b_im': s5_b_im, 's5_c_re': s5_c_re, 's5_c_im': s5_c_im,
            's5_d': s5_d, 's5_glu_w': s5_glu_w, 's5_glu_b': s5_glu_b,
            'hg_lb_logits': hg_lb_logits, 'hg_norm_g': hg_norm_g,
            'w_o_att': w_o_att, 'w_o_s5': w_o_s5, 'w_o_hg': w_o_hg, 'w_out': w_out,
            'moe_w_group': moe_w_group, 'moe_b_group': moe_b_group,
            'moe_w_expert': moe_w_expert, 'moe_b_expert': moe_b_expert,
            'moe_w_gate': moe_w_gate, 'moe_w_up': moe_w_up, 'moe_w_down': moe_w_down}


def reference(x, c, ctx, c_ctx, ada_w, ada_b, norm_mix_g, norm_ffn_g, w_in,
              q_norm_g, k_norm_g, diff_lambda, subln_g,
              s5_a_re, s5_a_im, s5_log_dt, s5_b_re, s5_b_im, s5_c_re, s5_c_im,
              s5_d, s5_glu_w, s5_glu_b, hg_lb_logits, hg_norm_g,
              w_o_att, w_o_s5, w_o_hg, w_out,
              moe_w_group, moe_b_group, moe_w_expert, moe_b_expert,
              moe_w_gate, moe_w_up, moe_w_down):
    bsz, n_lat, dm = x.shape
    rope = axial_rope(n_lat)
    p_lb = jax.nn.softmax(hg_lb_logits.astype(jnp.float32), axis=0)
    lower = jnp.cumsum(p_lb, axis=0) - p_lb[:1]
    c_act = jax.nn.silu(c)
    cc_act = jax.nn.silu(c_ctx)
    keep_all = (True,) * len(SECTION_WIDTHS)
    keep_ctx_last = (False, True, True, True, True, True, True, True, False, False)
    for l in range(DEPTH):
        need_ctx = l < DEPTH - 1
        mod = (c_act @ ada_w[l] + ada_b[l]).reshape(bsz, 1, 6, dm)
        mod_c = (cc_act @ ada_w[l] + ada_b[l]).reshape(1, 1, 6, dm)
        sh1, sc1, g1, sh2, sc2, g2 = (mod[:, :, i] for i in range(6))
        sh1c, sc1c, g1c, sh2c, sc2c, g2c = (mod_c[:, :, i] for i in range(6))

        hx = rms_norm(x, norm_mix_g[l]) * (1.0 + sc1) + sh1
        hc = rms_norm(ctx, norm_mix_g[l]) * (1.0 + sc1c) + sh1c
        px = project(hx, w_in[l], keep_all)
        pc = project(hc, w_in[l], keep_all if need_ctx else keep_ctx_last)

        lam_init = 0.8 - 0.6 * math.exp(-0.3 * l)
        lv = diff_lambda[l].astype(jnp.float32)
        lam = jnp.exp(jnp.sum(lv[0] * lv[1])) - jnp.exp(jnp.sum(lv[2] * lv[3])) + lam_init
        k_ctx = qk_heads(pc[1], k_norm_g[l], None)
        v_ctx = pc[2].reshape(bsz, -1, ATT_HEADS, ATT_DV)
        k_all = jnp.concatenate([k_ctx, qk_heads(px[1], k_norm_g[l], rope)], axis=1)
        v_all = jnp.concatenate([v_ctx, px[2].reshape(bsz, n_lat, ATT_HEADS, ATT_DV)], axis=1)
        q_lat = qk_heads(px[0], q_norm_g[l], rope)
        ya = diff_head_out(diff_attention(q_lat, k_all, v_all, lam), subln_g[l], lam_init)

        lam_f, b_f = s5_discretise(s5_a_re[l, 0], s5_a_im[l, 0], s5_log_dt[l, 0], s5_b_re[l], s5_b_im[l])
        lam_b, b_b = s5_discretise(s5_a_re[l, 1], s5_a_im[l, 1], s5_log_dt[l, 1], s5_b_re[l], s5_b_im[l])
        hs_cf = diag_scan(lam_f, s5_drive(pc[3], b_f), None, False)
        hs_cb = diag_scan(lam_b, s5_drive(pc[3], b_b), None, True)
        hs = (diag_scan(lam_f, s5_drive(px[3], b_f), hs_cf[:, -1], False)
              + diag_scan(lam_b, s5_drive(px[3], b_b), hs_cb[:, 0], True))
        s5_par = (s5_c_re[l], s5_c_im[l], s5_d[l], s5_glu_w[l], s5_glu_b[l])
        ys = s5_readout(hs, px[3], *s5_par)

        s0 = jnp.zeros((bsz, HG_HEADS, HG_DH, HG_DH), jnp.float32)
        kcf, gcf = hgrn_forget(pc[5], lower[l, 0])
        kcb, gcb = hgrn_forget(pc[6], lower[l, 1])
        oh_c, st_f, st_b = hgrn_bidir(jax.nn.silu(hgrn_heads(pc[4])), hgrn_heads(pc[7]), kcf, gcf, kcb, gcb, s0, s0)
        klf, glf = hgrn_forget(px[5], lower[l, 0])
        klb, glb = hgrn_forget(px[6], lower[l, 1])
        oh, _, _ = hgrn_bidir(jax.nn.silu(hgrn_heads(px[4])), hgrn_heads(px[7]), klf, glf, klb, glb, st_f, st_b)
        yh = hgrn_readout(oh, px[8], hg_norm_g[l])

        br = (w_o_att[l], w_o_s5[l], w_o_hg[l], w_out[l])
        x = x + g1 * merge_branches(ya, ys, yh, px[9], *br)
        moe_par = (moe_w_group[l], moe_b_group[l], moe_w_expert[l], moe_b_expert[l],
                   moe_w_gate[l], moe_w_up[l], moe_w_down[l])
        if need_ctx:
            q_c = qk_heads(pc[0], q_norm_g[l], None)
            ya_c = diff_head_out(diff_softmax_attend(q_c, k_ctx, v_ctx, lam), subln_g[l], lam_init)
            ys_c = s5_readout(hs_cf + hs_cb, pc[3], *s5_par)
            yh_c = hgrn_readout(oh_c, pc[8], hg_norm_g[l])
            ctx_mid = ctx + g1c * merge_branches(ya_c, ys_c, yh_c, pc[9], *br)
            hcf = rms_norm(ctx_mid, norm_ffn_g[l]) * (1.0 + sc2c) + sh2c
            ctx = ctx_mid + g2c * hier_moe(hcf.reshape(-1, dm), *moe_par).reshape(ctx_mid.shape)

        hxf = rms_norm(x, norm_ffn_g[l]) * (1.0 + sc2) + sh2
        x = x + g2 * hier_moe(hxf.reshape(-1, dm), *moe_par).reshape(x.shape)
    return x
```

```cpp
#include <hip/hip_runtime.h>
#include <cstdio>
#include <cstdint>

#define LAS __attribute__((address_space(3)))
#define GAS __attribute__((address_space(1)))
typedef unsigned short bf16;
typedef short bf16x8 __attribute__((ext_vector_type(8)));
typedef short s16x4 __attribute__((ext_vector_type(4)));
typedef float f32x2 __attribute__((ext_vector_type(2)));
typedef float f32x4 __attribute__((ext_vector_type(4)));
typedef float f32x16 __attribute__((ext_vector_type(16)));
typedef unsigned u32x4 __attribute__((ext_vector_type(4)));
typedef unsigned u32x2 __attribute__((ext_vector_type(2)));

constexpr int NB = 8, SEQ = 8192, CTX = 256, RB = SEQ + CTX, R = NB * RB, DM = 1024;
constexpr int NTILE = R / 256;
constexpr int TPB = RB / 256;
constexpr int NCH = RB / 64;
constexpr int NCHT = NB * NCH;
constexpr int SROWS = 1280;
constexpr int SLD = 1280;
constexpr int NEXP = 32;
constexpr int MAXTILES = 2 * NTILE + 64;
constexpr int NSLOT = MAXTILES * 256;
constexpr float RMS_EPS = 1e-6f;
constexpr float LOG2E = 1.4426950408889634f;

__device__ __forceinline__ int lane_id() { int r; asm volatile("v_mbcnt_lo_u32_b32 %0, -1, 0\n\tv_mbcnt_hi_u32_b32 %0, -1, %0" : "=v"(r)); return r; }
__device__ __forceinline__ float bf2f(bf16 h) { return __builtin_bit_cast(float, (unsigned)h << 16); }
typedef float f32x2_t __attribute__((ext_vector_type(2))); typedef __bf16 bf16x2_t __attribute__((ext_vector_type(2)));
__device__ __forceinline__ unsigned cvt_pk_bf16(float lo, float hi) { f32x2_t v = {lo, hi}; bf16x2_t b = __builtin_convertvector(v, bf16x2_t); return __builtin_bit_cast(unsigned, b); }
__device__ __forceinline__ bf16 f2bf(float f) { return (bf16)(cvt_pk_bf16(f, 0.f) & 0xffffu); }
__device__ __forceinline__ float fexp(float x) { return __builtin_amdgcn_exp2f(x * LOG2E); }
__device__ __forceinline__ float fsigmoid(float x) { return __builtin_amdgcn_rcpf(1.f + fexp(-x)); }
__device__ __forceinline__ float fsilu(float x) { return x * fsigmoid(x); }
__device__ __forceinline__ float fgelu_tanh(float x) { const float u = 0.7978845608028654f * (x + 0.044715f * x * x * x); const float t = 1.f - 2.f * __builtin_amdgcn_rcpf(fexp(2.f * u) + 1.f); return 0.5f * x * (1.f + t); }
__device__ __forceinline__ void unpack8(u32x4 w, float (&f)[8]) {
    f[0] = __builtin_bit_cast(float, w.x << 16); f[1] = __builtin_bit_cast(float, w.x & 0xffff0000u);
    f[2] = __builtin_bit_cast(float, w.y << 16); f[3] = __builtin_bit_cast(float, w.y & 0xffff0000u);
    f[4] = __builtin_bit_cast(float, w.z << 16); f[5] = __builtin_bit_cast(float, w.z & 0xffff0000u);
    f[6] = __builtin_bit_cast(float, w.w << 16); f[7] = __builtin_bit_cast(float, w.w & 0xffff0000u);
}
__device__ __forceinline__ u32x4 pack8(const float (&f)[8]) { u32x4 w; w.x = cvt_pk_bf16(f[0], f[1]); w.y = cvt_pk_bf16(f[2], f[3]); w.z = cvt_pk_bf16(f[4], f[5]); w.w = cvt_pk_bf16(f[6], f[7]); return w; }
__device__ __forceinline__ float shx(float v, int m, int lane) { return __builtin_bit_cast(float, __builtin_amdgcn_ds_bpermute((lane ^ m) << 2, __builtin_bit_cast(int, v))); }
__device__ __forceinline__ float wave_sum(float v, int lane) {
#pragma unroll
    for (int o = 1; o < 64; o <<= 1) v += shx(v, o, lane);
    return v;
}

namespace pg8 {
#define PG8_LAS __attribute__((address_space(3)))
typedef unsigned short bf16_t;
constexpr int BM = 256, BK = 64, HALF = 128, HTB = HALF * BK * 2  , STAGE_BYTES = 8 * HTB, NXCD = 8, WGM = 8;
__host__ __device__ __forceinline__ int lds_byte(int r, int c) { const int st = (r >> 4) * 2 + (c >> 5), rr = r & 15, cc = c & 31, ob = rr * 64 + cc * 2; return st * 1024 + (ob ^ (((ob >> 9) & 1) << 5)); }
__host__ __device__ __forceinline__ void stage_rc(int b, int& R, int& C) { const int st = b / 1024, sb = b % 1024, swz = sb ^ (((sb >> 9) & 1) << 5); R = (st >> 1) * 16 + swz / 64; C = (st & 1) * 32 + (swz % 64) / 2; }
__host__ __device__ __forceinline__ int perm32(int rho) { const int n = rho >> 4, i = rho & 15; return 8 * (i >> 2) + 4 * n + (i & 3); }
struct Unit { int pm, pn; };
struct Gemm { const bf16_t* A; const bf16_t* Bt; int M, N, K, lda, ldb; const bf16_t* A2; int ksplit, ksplit2; };
struct StaticOrder { static constexpr bool GATHER = false;
    int nM, nN, nwg, G, c;
    __host__ __device__ void init(int M, int N, int G_, int c_) { nM = M / BM; nN = N / BM; nwg = nM * nN; G = G_; c = c_; }
    __host__ __device__ bool next(int i, Unit& u) const {
        const long L = (long)i * G + c; if (L >= nwg) return false;
        int wgid = (int)L; { const int q = nwg / NXCD, r = nwg % NXCD, xcd = wgid % NXCD, off = wgid / NXCD; wgid = (xcd < r ? xcd * (q + 1) : r * (q + 1) + (xcd - r) * q) + off; }
        const int nig = WGM * nN, gid = wgid / nig, fm = gid * WGM, gsz = (nM - fm) < WGM ? (nM - fm) : WGM;
        u.pm = fm + ((wgid % nig) % gsz); u.pn = (wgid % nig) / gsz; return true;
    }
    __device__ __forceinline__ void a_ready(const Unit&) const {}
    __device__ __forceinline__ void done(const Unit&) const {}
};
template <class E> struct epi_fp8 { static constexpr bool v = false; };
typedef int v8i_t __attribute__((ext_vector_type(8)));
typedef int v4i_t __attribute__((ext_vector_type(4)));
template <class Epi, class Sched, bool ALIGN_EPI = false, bool SP2 = false>
__device__ __forceinline__ void gemm_phase(PG8_LAS unsigned char* lds, const Gemm g, const Sched& S, const Epi& E, const int wv) {
    int lane_ = lane_id(); asm volatile("" : "+v"(lane_)); const int tid = wv * 64 + lane_, wid = wv, lane = tid & 63, wr = wid >> 2, wc = wid & 3, fr = lane & 15, fq = lane >> 4;
    const int K = g.K, nt = K / BK;
    unsigned voffA0, voffB0;
    { int R, C; stage_rc(tid * 16, R, C); const int Rb = Epi::PERM ? ((R & ~31) + perm32(R & 31)) : R; voffA0 = (unsigned)(R * g.lda + C) * 2u; voffB0 = (unsigned)(Rb * g.ldb + C) * 2u; }
    const size_t pstepA = (size_t)64 * g.lda * 2, pstepB = (size_t)64 * g.ldb * 2;
    const size_t kstep = (size_t)(BK * 2);
    constexpr bool GA = Sched::GATHER; static_assert(!GA || SP2, "gathered A rows: SP2 loop only");
    const size_t hstepA = GA ? 0 : (size_t)HALF * g.lda * 2, hstepB = (size_t)HALF * g.ldb * 2;
    const size_t tstepA = 2 * hstepA, tstepB = 2 * hstepB;
    const unsigned ldsw = (unsigned)wid * 1024u;
    const int aoff = lds_byte(wr * 64 + fr, fq * 8), boff = lds_byte(wc * 32 + fr, fq * 8);
#define PG8_SA(b, h) (((b) * 2 + (h)) * HTB)
#define PG8_SB(b, h) ((4 + (b) * 2 + (h)) * HTB)
#define PG8_STAGE(bufoff, gbase, voff) do { _Pragma("unroll") for (int _i = 0; _i < 2; ++_i) \
        __builtin_amdgcn_global_load_lds((const unsigned*)((const char*)(gbase) + (voff)[_i]), (PG8_LAS unsigned*)(lds + (bufoff) + ldsw + _i * 8192), 16, 0, 0); } while (0)
#define PG8_STAGEU(bufoff, gbase, v0, pstep) do { _Pragma("unroll") for (int _i = 0; _i < 2; ++_i) \
        __builtin_amdgcn_global_load_lds((const unsigned*)((const char*)(gbase) + _i * (pstep) + (v0)), (PG8_LAS unsigned*)(lds + (bufoff) + ldsw + _i * 8192), 16, 0, 0); } while (0)
#define PG8_LD8(adr) __builtin_shufflevector(*(const PG8_LAS v4i_t*)(adr), *(const PG8_LAS v4i_t*)((adr) + 1024), 0, 1, 2, 3, 4, 5, 6, 7)
#define PG8_LDA(dst, b, h) do { if constexpr (epi_fp8<Epi>::v) { _Pragma("unroll") for (int m = 0; m < 4; ++m) dst##8[m] = PG8_LD8(lds + PG8_SA(b, h) + aoff + m * 2048); } \
        else { _Pragma("unroll") for (int m = 0; m < 4; ++m) _Pragma("unroll") for (int k = 0; k < 2; ++k) dst[m][k] = *(const PG8_LAS bf16x8*)(lds + PG8_SA(b, h) + aoff + m * 2048 + k * 1024); } } while (0)
#define PG8_LDB(dst, b, h) do { if constexpr (epi_fp8<Epi>::v) { _Pragma("unroll") for (int n = 0; n < 2; ++n) dst##8[n] = PG8_LD8(lds + PG8_SB(b, h) + boff + n * 2048); } \
        else { _Pragma("unroll") for (int n = 0; n < 2; ++n) _Pragma("unroll") for (int k = 0; k < 2; ++k) dst[n][k] = *(const PG8_LAS bf16x8*)(lds + PG8_SB(b, h) + boff + n * 2048 + k * 1024); } } while (0)
#define PG8_MMA(ai, bj, At, Bt) do { __builtin_amdgcn_s_setprio(1); \
        if constexpr (epi_fp8<Epi>::v) { _Pragma("unroll") for (int m = 0; m < 4; ++m) _Pragma("unroll") for (int n = 0; n < 2; ++n) \
            acc[ai][bj][m][n] = __builtin_amdgcn_mfma_scale_f32_16x16x128_f8f6f4(Bt##8[n], At##8[m], acc[ai][bj][m][n], 0, 0, 0, 0x7c7c7c7c, 0, 0x7c7c7c7c); } \
        else { _Pragma("unroll") for (int m = 0; m < 4; ++m) _Pragma("unroll") for (int n = 0; n < 2; ++n) _Pragma("unroll") for (int k = 0; k < 2; ++k) \
            acc[ai][bj][m][n] = __builtin_amdgcn_mfma_f32_16x16x32_bf16(Bt[n][k], At[m][k], acc[ai][bj][m][n], 0, 0, 0); } \
        __builtin_amdgcn_s_setprio(0); } while (0)
#define PG8_WAIT_V(n) asm volatile("s_waitcnt vmcnt(" #n ")" ::: "memory")
#define PG8_WAIT_L(n) asm volatile("s_waitcnt lgkmcnt(" #n ")" ::: "memory")
#define PG8_BAR __builtin_amdgcn_s_barrier()
#define PG8_SCHED __builtin_amdgcn_sched_barrier(0)
    Unit cur, nxt; int ui = 0;
    if (!S.next(0, cur)) return;
    unsigned vA[2][2] = {{0u, 0u}, {0u, 0u}}, vN[2][2] = {{0u, 0u}, {0u, 0u}};
#define PG8_GOFF(dst, un) do { if constexpr (GA) { _Pragma("unroll") for (int h_ = 0; h_ < 2; ++h_) _Pragma("unroll") for (int i_ = 0; i_ < 2; ++i_) { int R_, C_; stage_rc(tid * 16 + i_ * 8192, R_, C_); \
        dst[h_][i_] = (unsigned)(S.arow(un, h_ * 128 + R_) * g.lda + C_) * 2u; } } } while (0)
#define PG8_ASTG(b, h, base, nextsel) do { if constexpr (GA) { if (nextsel) { PG8_STAGE(PG8_SA(b, h), base, vN[h]); } else { PG8_STAGE(PG8_SA(b, h), base, vA[h]); } } else { PG8_STAGEU(PG8_SA(b, h), base, voffA0, pstepA); } } while (0)
    PG8_GOFF(vA, cur);
    f32x4 acc[2][2][4][2];
#pragma unroll
    for (int a = 0; a < 2; ++a)
#pragma unroll
        for (int b = 0; b < 2; ++b)
#pragma unroll
            for (int m = 0; m < 4; ++m)
#pragma unroll
                for (int n = 0; n < 2; ++n) acc[a][b][m][n] = (f32x4){0.f, 0.f, 0.f, 0.f};
    bf16x8 At[4][2], B0[2][2], B1[2][2]; v8i_t At8[4], B08[2], B18[2]; (void)At; (void)B0; (void)B1; (void)At8; (void)B08; (void)B18;
    const char* cA = (const char*)g.A + (size_t)cur.pm * tstepA; const char* cB = (const char*)g.Bt + (size_t)cur.pn * tstepB;
    const char* cA2 = nullptr; if constexpr (Epi::SEG2) cA2 = (const char*)g.A2 + (size_t)cur.pm * tstepA - (size_t)g.ksplit * (BK * 2);
    S.a_ready(cur);
    if constexpr (SP2) {
        PG8_STAGEU(PG8_SB(0, 0), cB, voffB0, pstepB); PG8_STAGEU(PG8_SB(0, 1), cB + hstepB, voffB0, pstepB); PG8_ASTG(0, 0, cA, false); PG8_ASTG(0, 1, cA + hstepA, false);
        if (wr == 1) PG8_BAR;
        PG8_WAIT_V(2); PG8_BAR;
        PG8_STAGEU(PG8_SB(1, 0), cB + kstep, voffB0, pstepB); PG8_ASTG(1, 0, cA + kstep, false); PG8_STAGEU(PG8_SB(1, 1), cB + hstepB + kstep, voffB0, pstepB);
        PG8_WAIT_V(6); PG8_BAR;
    } else {
        PG8_STAGEU(PG8_SB(0, 0), cB, voffB0, pstepB); PG8_STAGEU(PG8_SA(0, 0), cA, voffA0, pstepA); PG8_STAGEU(PG8_SB(0, 1), cB + hstepB, voffB0, pstepB); PG8_STAGEU(PG8_SA(0, 1), cA + hstepA, voffA0, pstepA);
        if (wr == 1) PG8_BAR;
        PG8_WAIT_V(4); PG8_BAR;
        PG8_STAGEU(PG8_SB(1, 0), cB + kstep, voffB0, pstepB); PG8_STAGEU(PG8_SA(1, 0), cA + kstep, voffA0, pstepA); PG8_STAGEU(PG8_SB(1, 1), cB + hstepB + kstep, voffB0, pstepB);
        PG8_WAIT_V(6); PG8_BAR;
    }
    for (;;) {
        const bool has_next = S.next(ui + 1, nxt);
        if constexpr (GA) { if (has_next) PG8_GOFF(vN, nxt); else { vN[0][0] = vA[0][0]; vN[0][1] = vA[0][1]; vN[1][0] = vA[1][0]; vN[1][1] = vA[1][1]; } }
        const char* nA2 = nullptr; if constexpr (Epi::SEG2) nA2 = has_next ? (const char*)g.A2 + (size_t)nxt.pm * tstepA - (size_t)g.ksplit * (BK * 2) : cA2;
        const char* nA = has_next ? (const char*)g.A + (size_t)nxt.pm * tstepA : cA; const char* nB = has_next ? (const char*)g.Bt + (size_t)nxt.pn * tstepB : cB;
#pragma clang loop unroll(disable)
        for (int t = 0; t < nt; t += 2) {
            const bool last = (t == nt - 2);
            asm volatile("" : "+v"(voffA0), "+v"(voffB0));
            if constexpr (Epi::MID) { if (t == g.ksplit || t == g.ksplit2) { const int l3 = lane_id(); E.mid(acc, cur, t, wr, wc, l3 & 15, l3 >> 4); } }
            const char* a1 = ((Epi::SEG2 && t + 1 >= g.ksplit) ? cA2 : cA) + (size_t)(t + 1) * kstep;
            const char* a2 = last ? nA : ((Epi::SEG2 && t + 2 >= g.ksplit) ? cA2 : cA) + (size_t)(t + 2) * kstep; const char* b2 = last ? nB : cB + (size_t)(t + 2) * kstep;
            const char* a3 = a2 + kstep; const char* b3 = b2 + kstep;
            if (last && has_next) S.a_ready(nxt);
            if constexpr (SP2) {
            PG8_LDB(B0, 0, 0); PG8_LDB(B1, 0, 1); PG8_SCHED; PG8_LDA(At, 0, 0); PG8_ASTG(1, 1, a1 + hstepA, false);
            PG8_WAIT_V(8); PG8_WAIT_L(0); PG8_BAR; PG8_MMA(0, 0, At, B0); PG8_MMA(0, 1, At, B1); PG8_BAR; PG8_SCHED;
            PG8_LDA(At, 0, 1); PG8_STAGEU(PG8_SB(0, 0), b2, voffB0, pstepB); PG8_STAGEU(PG8_SB(0, 1), b2 + hstepB, voffB0, pstepB); PG8_ASTG(0, 0, a2, last);
            PG8_WAIT_V(8); PG8_WAIT_L(0); PG8_BAR; PG8_MMA(1, 0, At, B0); PG8_MMA(1, 1, At, B1); PG8_BAR; PG8_SCHED;
            PG8_LDB(B0, 1, 0); PG8_LDB(B1, 1, 1); PG8_SCHED; PG8_LDA(At, 1, 0); PG8_ASTG(0, 1, a2 + hstepA, last);
            PG8_WAIT_V(8); PG8_WAIT_L(0); PG8_BAR; PG8_MMA(0, 0, At, B0); PG8_MMA(0, 1, At, B1); PG8_BAR; PG8_SCHED;
            PG8_LDA(At, 1, 1); PG8_STAGEU(PG8_SB(1, 0), b3, voffB0, pstepB); PG8_STAGEU(PG8_SB(1, 1), b3 + hstepB, voffB0, pstepB); PG8_ASTG(1, 0, a3, last);
            PG8_WAIT_V(8); PG8_WAIT_L(0); PG8_BAR; PG8_MMA(1, 0, At, B0); PG8_MMA(1, 1, At, B1); PG8_BAR; PG8_SCHED;
            } else {
            PG8_LDB(B0, 0, 0); PG8_SCHED; PG8_LDA(At, 0, 0); PG8_STAGEU(PG8_SA(1, 1), a1 + hstepA, voffA0, pstepA);
            PG8_WAIT_L(8); PG8_BAR; PG8_WAIT_L(0); PG8_MMA(0, 0, At, B0); PG8_BAR; PG8_SCHED;
            PG8_LDB(B1, 0, 1); PG8_STAGEU(PG8_SB(0, 0), b2, voffB0, pstepB);
            PG8_BAR; PG8_WAIT_L(0); PG8_MMA(0, 1, At, B1); PG8_BAR;
            PG8_LDA(At, 0, 1); PG8_STAGEU(PG8_SA(0, 0), a2, voffA0, pstepA);
            PG8_BAR; PG8_WAIT_L(0); PG8_MMA(1, 0, At, B0); PG8_BAR; PG8_SCHED;
            PG8_STAGEU(PG8_SB(0, 1), b2 + hstepB, voffB0, pstepB);
            PG8_WAIT_V(6); PG8_BAR; PG8_MMA(1, 1, At, B1); PG8_BAR;
            PG8_LDB(B0, 1, 0); PG8_SCHED; PG8_LDA(At, 1, 0); PG8_STAGEU(PG8_SA(0, 1), a2 + hstepA, voffA0, pstepA);
            PG8_WAIT_L(8); PG8_BAR; PG8_WAIT_L(0); PG8_MMA(0, 0, At, B0); PG8_BAR; PG8_SCHED;
            PG8_LDB(B1, 1, 1); PG8_STAGEU(PG8_SB(1, 0), b3, voffB0, pstepB);
            PG8_BAR; PG8_WAIT_L(0); PG8_MMA(0, 1, At, B1); PG8_BAR;
            PG8_LDA(At, 1, 1); PG8_STAGEU(PG8_SA(1, 0), a3, voffA0, pstepA);
            PG8_BAR; PG8_WAIT_L(0); PG8_MMA(1, 0, At, B0); PG8_BAR; PG8_SCHED;
            PG8_STAGEU(PG8_SB(1, 1), b3 + hstepB, voffB0, pstepB);
            PG8_WAIT_V(6); PG8_BAR; PG8_MMA(1, 1, At, B1); PG8_BAR;
            }
        }
        if constexpr (ALIGN_EPI) { if (wr == 0) PG8_BAR; }
        if constexpr (!Epi::AFTER_DRAIN) { const int l2 = lane_id(); E(acc, cur, wr, wc, l2 & 15, l2 >> 4); S.done(cur); }
        if (!has_next) break;
#pragma unroll
        for (int a = 0; a < 2; ++a)
#pragma unroll
            for (int b = 0; b < 2; ++b)
#pragma unroll
                for (int m = 0; m < 4; ++m)
#pragma unroll
                    for (int n = 0; n < 2; ++n) acc[a][b][m][n] = (f32x4){0.f, 0.f, 0.f, 0.f};
        cur = nxt; cA = nA; cB = nB; ++ui; if constexpr (Epi::SEG2) cA2 = nA2;
        if constexpr (GA) { vA[0][0] = vN[0][0]; vA[0][1] = vN[0][1]; vA[1][0] = vN[1][0]; vA[1][1] = vN[1][1]; }
        if constexpr (ALIGN_EPI) { if (wr == 1) PG8_BAR; }
    }
    PG8_WAIT_V(0);
    if constexpr (!ALIGN_EPI) { if (wr == 0) PG8_BAR; }
    PG8_BAR;
    if constexpr (Epi::AFTER_DRAIN) { E.fused(acc, cur, wr, wc, fr, fq, lds, wid, lane); S.done(cur); }
#undef PG8_SA
#undef PG8_GOFF
#undef PG8_ASTG
#undef PG8_SB
#undef PG8_STAGE
#undef PG8_LDA
#undef PG8_LDB
#undef PG8_MMA
#undef PG8_WAIT_V
#undef PG8_WAIT_L
#undef PG8_BAR
#undef PG8_SCHED
}
}

using pg8::Unit;
struct S5Order { static constexpr bool GATHER = false;
    int nct, total, G, c;
    __device__ void init(int nct_, int G_, int c_) { nct = nct_; total = 16 * 5 * nct_; G = G_; c = c_; }
    __device__ bool next(int i, Unit& u) const { const int L = i * G + c; if (L >= total) return false; const int per = 5 * nct, g = L / per, rem = L - g * per; const int ct = rem / 5, rt = rem - ct * 5;
        u.pm = g * 5 + rt; u.pn = g * nct + ct; return true; }
    __device__ __forceinline__ void a_ready(const Unit&) const {}
    __device__ __forceinline__ void done(const Unit&) const {}
};
template <bool GA> struct MoeOrderT {
    static constexpr bool GATHER = GA;
    const int* tile_e; const int* slot_row; int t0, total, G, c;
    __device__ void init(const int* te, const int* sr, int t0_, int nt_, int G_, int c_) { tile_e = te; slot_row = sr; t0 = t0_; total = nt_ * 4; G = G_; c = c_; }
    __device__ bool next(int i, Unit& u) const { const int L = i * G + c; if (L >= total) return false; const int tile = t0 + (L >> 2); u.pm = tile; u.pn = tile_e[tile] * 4 + (L & 3); return true; }
    __device__ __forceinline__ int arow(const Unit& u, int r) const { const int t = slot_row[u.pm * 256 + r]; return t < 0 ? 0 : t; }
    __device__ __forceinline__ void a_ready(const Unit&) const {}
    __device__ __forceinline__ void done(const Unit&) const {}
};

struct InprojOrder { static constexpr bool GATHER = false;
    pg8::StaticOrder so;
    __device__ void init(int M, int G_, int c_) { so.init(M, 11 * 256, G_, c_); }
    __device__ bool next(int i, Unit& u) const { if (!so.next(i, u)) return false; if (u.pn >= 6) u.pn += 1; return true; }
    __device__ __forceinline__ void a_ready(const Unit&) const {}
    __device__ __forceinline__ void done(const Unit&) const {}
};

struct RowOrder { static constexpr bool GATHER = false;
    pg8::StaticOrder so; bool skip;
    __device__ void init(int N, int G_, int c_, bool skip_ctx) { skip = skip_ctx; so.init(skip_ctx ? NB * SEQ : R, N, G_, c_); }
    __device__ bool next(int i, Unit& u) const { if (!so.next(i, u)) return false; if (skip) u.pm += (u.pm >> 5) + 1; return true; }
    __device__ __forceinline__ void a_ready(const Unit&) const {}
    __device__ __forceinline__ void done(const Unit&) const {}
};

#define EPI_ROWS_BEGIN _Pragma("unroll") for (int ai = 0; ai < 2; ++ai) _Pragma("unroll") for (int m = 0; m < 4; ++m) { const int trow = ai * 128 + wr * 64 + m * 16 + fr;
#define EPI_COLS_BEGIN _Pragma("unroll") for (int bj = 0; bj < 2; ++bj) { const int cc = bj * 128 + wc * 32 + 8 * fq; f32x4 v0 = acc[ai][bj][m][0], v1 = acc[ai][bj][m][1]; asm volatile("" : "+v"(v0), "+v"(v1) :: "memory");
#define EPI_END } }
typedef const f32x4 (&AccRef)[2][2][4][2];
#define EPIB_BEGIN _Pragma("unroll") for (int ai = 0; ai < 2; ++ai) _Pragma("unroll") for (int mh = 0; mh < 2; ++mh) {
#define EPIB_ITEMS _Pragma("unroll") for (int mm = 0; mm < 2; ++mm) _Pragma("unroll") for (int bj = 0; bj < 2; ++bj) { const int m = mh * 2 + mm, it4 = mm * 2 + bj, trow = ai * 128 + wr * 64 + m * 16 + fr, cc = bj * 128 + wc * 32 + 8 * fq; (void)it4; (void)trow; (void)cc;
#define EPIB_FENCE } asm volatile("" ::: "memory");
#define EPIB_END }

struct EpiInproj { static constexpr bool PERM = true, AFTER_DRAIN = false, SEG2 = false, MID = false;
    bf16 *Q, *K, *H5, *AG; const float *kg, *rope;
    __device__ __forceinline__ void operator()(AccRef acc, const Unit& u, int wr, int wc, int fr, int fq) const {
        const int pn = u.pn; const bool isag = (pn == 4);
        if (pn == 2 || pn == 3) {
            const int lane = fq * 16 + fr, s64 = ((pn - 2) * 4 + wc) * 64;
            const f32x4 g0a = *(const f32x4*)(kg + 8 * fq), g0b = *(const f32x4*)(kg + 8 * fq + 4), g1a = *(const f32x4*)(kg + 32 + 8 * fq), g1b = *(const f32x4*)(kg + 36 + 8 * fq);
            const int bb = u.pm / TPB; const bool lat = (u.pm - bb * TPB) != 0;
#pragma unroll
            for (int ai = 0; ai < 2; ++ai) {
                f32x4 cz[4][2], sz[4][2];
#pragma unroll
                for (int m = 0; m < 4; ++m) { const int t = lat ? (u.pm - bb * TPB) * 256 + ai * 128 + wr * 64 + m * 16 + fr - CTX : 0; const float* cs = rope + (size_t)t * 32 + 8 * fq; const float* sn = cs + (size_t)SEQ * 32;
                    cz[m][0] = *(const f32x4*)cs; cz[m][1] = *(const f32x4*)(cs + 4); sz[m][0] = *(const f32x4*)sn; sz[m][1] = *(const f32x4*)(sn + 4); }
                asm volatile("" ::: "memory");
#pragma unroll
                for (int m = 0; m < 4; ++m) { const int trow = ai * 128 + wr * 64 + m * 16 + fr; const size_t row = (size_t)u.pm * 256 + trow;
                    f32x4 a0 = acc[ai][0][m][0], a1 = acc[ai][0][m][1], b0 = acc[ai][1][m][0], b1 = acc[ai][1][m][1];
                    const f32x4 one = {1.f, 1.f, 1.f, 1.f}, zero = {0.f, 0.f, 0.f, 0.f};
                    const f32x4 c0 = lat ? cz[m][0] : one, c1 = lat ? cz[m][1] : one, s0 = lat ? sz[m][0] : zero, s1 = lat ? sz[m][1] : zero;
                    float ss = 0.f;
#pragma unroll
                    for (int e = 0; e < 4; ++e) ss += a0[e] * a0[e] + a1[e] * a1[e] + b0[e] * b0[e] + b1[e] * b1[e];
                    ss += shx(ss, 16, lane); ss += shx(ss, 32, lane);
                    const float rinv = __builtin_amdgcn_rsqf(ss * (1.f / 64.f) + RMS_EPS);
                    a0 = a0 * rinv * g0a; a1 = a1 * rinv * g0b; b0 = b0 * rinv * g1a; b1 = b1 * rinv * g1b;
                    const f32x4 lo0 = a0 * c0 - b0 * s0, lo1 = a1 * c1 - b1 * s1, hi0 = b0 * c0 + a0 * s0, hi1 = b1 * c1 + a1 * s1;
                    unsigned char* kp = (unsigned char*)K + row * 512 + s64 + 32 * (fq & 1) + 8 * (fq >> 1);
                    u32x2 w; int t0 = 0, t1 = 0; t0 = __builtin_amdgcn_cvt_pk_fp8_f32(lo0[0], lo0[1], t0, false); t0 = __builtin_amdgcn_cvt_pk_fp8_f32(lo0[2], lo0[3], t0, true);
                    t1 = __builtin_amdgcn_cvt_pk_fp8_f32(lo1[0], lo1[1], t1, false); t1 = __builtin_amdgcn_cvt_pk_fp8_f32(lo1[2], lo1[3], t1, true); w.x = (unsigned)t0; w.y = (unsigned)t1; *(u32x2*)kp = w;
                    t0 = 0; t1 = 0; t0 = __builtin_amdgcn_cvt_pk_fp8_f32(hi0[0], hi0[1], t0, false); t0 = __builtin_amdgcn_cvt_pk_fp8_f32(hi0[2], hi0[3], t0, true);
                    t1 = __builtin_amdgcn_cvt_pk_fp8_f32(hi1[0], hi1[1], t1, false); t1 = __builtin_amdgcn_cvt_pk_fp8_f32(hi1[2], hi1[3], t1, true); w.x = (unsigned)t0; w.y = (unsigned)t1; *(u32x2*)(kp + 16) = w; }
            }
            return;
        }
        bf16* base; int ld;
        if (pn < 4) { base = Q + (size_t)(pn >> 1) * ((size_t)R * 512) + (pn & 1) * 256; ld = 512; } else if (isag) { base = AG; ld = 0; } else { base = H5 + (size_t)(pn - 5) * ((size_t)R * 256); ld = 256; }
        EPI_ROWS_BEGIN const int row = u.pm * 256 + trow;
            const size_t rterm = isag ? (size_t)(row >> 6) * SLD + (row & 63) * 16 : (size_t)row * ld;
        EPI_COLS_BEGIN
            u32x4 w; w.x = cvt_pk_bf16(v0[0], v0[1]); w.y = cvt_pk_bf16(v0[2], v0[3]); w.z = cvt_pk_bf16(v1[0], v1[1]); w.w = cvt_pk_bf16(v1[2], v1[3]);
            const size_t cterm = isag ? (size_t)(cc >> 4) * ((size_t)SROWS * SLD) + (cc & 15) : (size_t)cc;
            *(u32x4*)(base + rterm + cterm) = w;
        EPI_END
    }
};
struct EpiVT { static constexpr bool PERM = true, AFTER_DRAIN = false, SEG2 = false, MID = false;
    unsigned char* VT;
    __device__ __forceinline__ void operator()(AccRef acc, const Unit& u, int wr, int wc, int fr, int fq) const {
        const int b = u.pn / TPB, tok0 = (u.pn - b * TPB) * 256;
        EPI_ROWS_BEGIN const int dvg = u.pm * 256 + trow; unsigned char* rowp = VT + ((size_t)b * 512 + dvg) * RB + tok0;
        EPI_COLS_BEGIN
            const int blk = cc & ~63, j0 = (cc & 63) >> 1;
            int w0 = 0, w1 = 0; w0 = __builtin_amdgcn_cvt_pk_fp8_f32(v0[0], v0[1], w0, false); w0 = __builtin_amdgcn_cvt_pk_fp8_f32(v0[2], v0[3], w0, true);
            w1 = __builtin_amdgcn_cvt_pk_fp8_f32(v1[0], v1[1], w1, false); w1 = __builtin_amdgcn_cvt_pk_fp8_f32(v1[2], v1[3], w1, true);
            *(int*)(rowp + blk + j0) = w0; *(int*)(rowp + blk + 32 + j0) = w1;
        EPI_END
    }
};
namespace pg8 { template <> struct epi_fp8<EpiInproj> { static constexpr bool v = true; }; template <> struct epi_fp8<EpiVT> { static constexpr bool v = true; }; }
struct EpiS5U { static constexpr bool PERM = true, AFTER_DRAIN = false, SEG2 = false, MID = false;
    bf16* AG;
    __device__ __forceinline__ void operator()(AccRef acc, const Unit& u, int wr, int wc, int fr, int fq) const {
        EPI_ROWS_BEGIN const int row = u.pm * 256 + trow;
        EPI_COLS_BEGIN
            u32x4 w; w.x = cvt_pk_bf16(v0[0], v0[1]); w.y = cvt_pk_bf16(v0[2], v0[3]); w.z = cvt_pk_bf16(v1[0], v1[1]); w.w = cvt_pk_bf16(v1[2], v1[3]);
            *(u32x4*)(AG + ((size_t)((cc >> 4) * SROWS + (row >> 6))) * SLD + (row & 63) * 16 + (cc & 15)) = w;
        EPI_END
    }
};
__device__ __forceinline__ size_t gtile_off(int pm, int pnG, int wr, int wc, int fr, int fq, int ai, int m, int bj) { return ((size_t)(pm * 12 + pnG) << 16) + (size_t)((((wr * 4 + wc) * 16 + (ai * 8 + m * 2 + bj)) * 64 + (fq * 16 + fr)) * 8); }
__device__ __forceinline__ unsigned gq8(float z) { return (unsigned)__builtin_amdgcn_rcpf(fmaf(__builtin_amdgcn_exp2f(z), 0.00390625f, 0.00390625f * (1.f + 1.f / 4096.f))); }
__device__ __forceinline__ void gdq8(u32x2 w, float (&g)[8]) {
    g[0] = ((float)(w.x & 255u) + 0.5f) * (1.f / 256.f); g[1] = ((float)((w.x >> 8) & 255u) + 0.5f) * (1.f / 256.f); g[2] = ((float)((w.x >> 16) & 255u) + 0.5f) * (1.f / 256.f); g[3] = ((float)(w.x >> 24) + 0.5f) * (1.f / 256.f);
    g[4] = ((float)(w.y & 255u) + 0.5f) * (1.f / 256.f); g[5] = ((float)((w.y >> 8) & 255u) + 0.5f) * (1.f / 256.f); g[6] = ((float)((w.y >> 16) & 255u) + 0.5f) * (1.f / 256.f); g[7] = ((float)(w.y >> 24) + 0.5f) * (1.f / 256.f);
}
struct EpiGates { static constexpr bool PERM = true, AFTER_DRAIN = false, SEG2 = false, MID = false;
    unsigned char* G;
    __device__ __forceinline__ void operator()(AccRef acc, const Unit& u, int wr, int wc, int fr, int fq) const {
        EPI_ROWS_BEGIN
        EPI_COLS_BEGIN
            u32x2 w; w.x = gq8(v0[0]) | (gq8(v0[1]) << 8) | (gq8(v0[2]) << 16) | (gq8(v0[3]) << 24); w.y = gq8(v1[0]) | (gq8(v1[1]) << 8) | (gq8(v1[2]) << 16) | (gq8(v1[3]) << 24);
            *(u32x2*)(G + gtile_off(u.pm, u.pn, wr, wc, fr, fq, ai, m, bj)) = w;
        EPI_END
    }
};
namespace pg8 { template <> struct epi_fp8<EpiGates> { static constexpr bool v = true; }; }
struct EpiMerge { static constexpr bool PERM = true, AFTER_DRAIN = false, SEG2 = true, MID = true;
    const unsigned char* G; bf16* M;
    __device__ __forceinline__ void mid(f32x4 (&acc)[2][2][4][2], const Unit& u, int t, int wr, int wc, int fr, int fq) const {
        const int bra = (t == 8) ? 0 : 1;
        u32x2 ra[2][4][2], rb[2][4][2];
#pragma unroll
        for (int ai = 0; ai < 2; ++ai)
#pragma unroll
            for (int m = 0; m < 4; ++m)
#pragma unroll
                for (int bj = 0; bj < 2; ++bj) { ra[ai][m][bj] = *(const u32x2*)(G + gtile_off(u.pm, bra * 4 + u.pn, wr, wc, fr, fq, ai, m, bj)); rb[ai][m][bj] = *(const u32x2*)(G + gtile_off(u.pm, (bra + 1) * 4 + u.pn, wr, wc, fr, fq, ai, m, bj)); }
        asm volatile("" ::: "memory");
#pragma unroll
        for (int ai = 0; ai < 2; ++ai)
#pragma unroll
            for (int m = 0; m < 4; ++m)
#pragma unroll
                for (int bj = 0; bj < 2; ++bj) { float ga[8], gb[8]; gdq8(ra[ai][m][bj], ga); gdq8(rb[ai][m][bj], gb);
#pragma unroll
                    for (int e = 0; e < 8; ++e) ga[e] = ga[e] * __builtin_amdgcn_rcpf(gb[e]);
                    acc[ai][bj][m][0] *= (f32x4){ga[0], ga[1], ga[2], ga[3]}; acc[ai][bj][m][1] *= (f32x4){ga[4], ga[5], ga[6], ga[7]}; }
    }
    __device__ __forceinline__ void operator()(AccRef acc, const Unit& u, int wr, int wc, int fr, int fq) const {
        EPIB_BEGIN
            u32x2 gr[4];
            EPIB_ITEMS gr[it4] = *(const u32x2*)(G + gtile_off(u.pm, 8 + u.pn, wr, wc, fr, fq, ai, m, bj)); EPIB_FENCE
            EPIB_ITEMS const f32x4 v0 = acc[ai][bj][m][0], v1 = acc[ai][bj][m][1];
                float g[8]; gdq8(gr[it4], g);
                const float o[8] = {g[0] * v0[0], g[1] * v0[1], g[2] * v0[2], g[3] * v0[3], g[4] * v1[0], g[5] * v1[1], g[6] * v1[2], g[7] * v1[3]};
                *(u32x4*)(M + (size_t)(u.pm * 256 + trow) * 1024 + u.pn * 256 + cc) = pack8(o); }
        EPIB_END
    }
};
struct EpiWout { static constexpr bool PERM = true, AFTER_DRAIN = false, SEG2 = false, MID = false;
    const void* xin_lat; const float* xin_ctx; bf16* xo_lat; float* xo_ctx; const float* modl; int inbf;
    __device__ __forceinline__ void operator()(AccRef acc, const Unit& u, int wr, int wc, int fr, int fq) const {
        const int b = u.pm / TPB, t = u.pm - b * TPB; const bool isctx = (t == 0), rdbf = !isctx && inbf;
        const size_t lrow0 = (size_t)(b * SEQ + (isctx ? 0 : t - 1) * 256);
        const float* xi = isctx ? xin_ctx + (size_t)(b * CTX) * DM : (const float*)xin_lat + lrow0 * DM;
        const bf16* xib = (const bf16*)xin_lat + lrow0 * DM;
        float* xo = xo_ctx + (size_t)(b * CTX) * DM; bf16* xob = xo_lat + lrow0 * DM;
        const float* g1 = modl + (size_t)((isctx ? 8 : b) * 6 + 2) * DM + u.pn * 256 + wc * 32 + 8 * fq;
        f32x4 gg[2][2];
#pragma unroll
        for (int bj = 0; bj < 2; ++bj) { gg[bj][0] = *(const f32x4*)(g1 + bj * 128); gg[bj][1] = *(const f32x4*)(g1 + bj * 128 + 4); }
        EPIB_BEGIN
            f32x4 xa[4], xb[4];
            EPIB_ITEMS const size_t eo = (size_t)trow * DM + u.pn * 256 + cc;
                if (rdbf) { const u32x4 r = *(const u32x4*)(xib + eo); xa[it4] = __builtin_bit_cast(f32x4, r); xb[it4] = xa[it4]; }
                else { xa[it4] = *(const f32x4*)(xi + eo); xb[it4] = *(const f32x4*)(xi + eo + 4); } EPIB_FENCE
            EPIB_ITEMS const size_t eo = (size_t)trow * DM + u.pn * 256 + cc; f32x4 x0 = xa[it4], x1 = xb[it4];
                if (rdbf) { float t8[8]; unpack8(__builtin_bit_cast(u32x4, xa[it4]), t8); x0 = (f32x4){t8[0], t8[1], t8[2], t8[3]}; x1 = (f32x4){t8[4], t8[5], t8[6], t8[7]}; }
                const f32x4 y0 = x0 + gg[bj][0] * acc[ai][bj][m][0], y1 = x1 + gg[bj][1] * acc[ai][bj][m][1];
                if (isctx) { *(f32x4*)(xo + eo) = y0; *(f32x4*)(xo + eo + 4) = y1; }
                else { u32x4 w; w.x = cvt_pk_bf16(y0[0], y0[1]); w.y = cvt_pk_bf16(y0[2], y0[3]); w.z = cvt_pk_bf16(y1[0], y1[1]); w.w = cvt_pk_bf16(y1[2], y1[3]); *(u32x4*)(xob + eo) = w; } }
        EPIB_END
    }
};
struct EpiRouter { static constexpr bool PERM = true, AFTER_DRAIN = false, SEG2 = false, MID = false;
    float* RT;
    __device__ __forceinline__ void operator()(AccRef acc, const Unit& u, int wr, int wc, int fr, int fq) const {
        EPI_ROWS_BEGIN const int row = u.pm * 256 + trow;
        EPI_COLS_BEGIN
            if (cc < 64) { *(f32x4*)(RT + (size_t)row * 64 + cc) = v0; *(f32x4*)(RT + (size_t)row * 64 + cc + 4) = v1; }
        EPI_END
    }
};
struct EpiS5E { static constexpr bool PERM = true, AFTER_DRAIN = false, SEG2 = false, MID = false;
    float* E;
    __device__ __forceinline__ void operator()(AccRef acc, const Unit& u, int wr, int wc, int fr, int fq) const {
        const int g = u.pm / 5, rt = u.pm - g * 5;
        EPI_ROWS_BEGIN const int crow = rt * 256 + trow;
        EPI_COLS_BEGIN
            if (crow < NCHT) { float* ep = E + ((size_t)(g * NCHT + crow)) * 256 + cc; *(f32x4*)ep = v0; *(f32x4*)(ep + 4) = v1; }
        EPI_END
    }
};
struct EpiS5Out { static constexpr bool PERM = true, AFTER_DRAIN = false, SEG2 = false, MID = false;
    const bf16* AG; const float* dvec; bf16* Z;
    __device__ __forceinline__ void operator()(AccRef acc, const Unit& u, int wr, int wc, int fr, int fq) const {
        const int g = u.pm / 5, rt = u.pm - g * 5, ct = u.pn - g * 4;
        f32x4 dd[2][2];
#pragma unroll
        for (int bj = 0; bj < 2; ++bj) { const int h0 = (bj * 128 + wc * 32 + 8 * fq) & 15; dd[bj][0] = *(const f32x4*)(dvec + g * 16 + h0); dd[bj][1] = *(const f32x4*)(dvec + g * 16 + h0 + 4); }
        EPIB_BEGIN
            u32x4 ur[4];
            EPIB_ITEMS const int crow = rt * 256 + trow; ur[it4] = *(const u32x4*)(AG + ((size_t)(g * SROWS + crow)) * SLD + ct * 256 + cc); EPIB_FENCE
            EPIB_ITEMS const int crow = rt * 256 + trow; const f32x4 v0 = acc[ai][bj][m][0], v1 = acc[ai][bj][m][1];
                if (crow < NCHT) { const int ncol = ct * 256 + cc, j = ncol >> 4, h0 = ncol & 15; float uu[8]; unpack8(ur[it4], uu);
                    float o[8] = {v0[0] + dd[bj][0][0] * uu[0], v0[1] + dd[bj][0][1] * uu[1], v0[2] + dd[bj][0][2] * uu[2], v0[3] + dd[bj][0][3] * uu[3], v1[0] + dd[bj][1][0] * uu[4], v1[1] + dd[bj][1][1] * uu[5], v1[2] + dd[bj][1][2] * uu[6], v1[3] + dd[bj][1][3] * uu[7]};
#pragma unroll
                    for (int e = 0; e < 8; ++e) o[e] = fgelu_tanh(o[e]);
                    *(u32x4*)(Z + ((size_t)crow * 64 + j) * 512 + g * 16 + h0) = pack8(o); } }
        EPIB_END
    }
};
struct EpiGlu { static constexpr bool PERM = true, AFTER_DRAIN = false, SEG2 = false, MID = false;
    bf16* Z; const float* bias;
    __device__ __forceinline__ void operator()(AccRef acc, const Unit& u, int wr, int wc, int fr, int fq) const {
        f32x4 bb[2][2];
#pragma unroll
        for (int bj = 0; bj < 2; ++bj) { const float* bp = bias + bj * 128 + wc * 32 + 8 * fq; bb[bj][0] = *(const f32x4*)bp; bb[bj][1] = *(const f32x4*)(bp + 4); }
        EPIB_BEGIN
            u32x4 zr[4];
            EPIB_ITEMS zr[it4] = *(const u32x4*)(Z + (size_t)(u.pm * 256 + trow) * 512 + cc); EPIB_FENCE
            EPIB_ITEMS const f32x4 v0 = acc[ai][bj][m][0] + bb[bj][0], v1 = acc[ai][bj][m][1] + bb[bj][1]; float z[8]; unpack8(zr[it4], z);
                const float o[8] = {z[0] * fsigmoid(v0[0]), z[1] * fsigmoid(v0[1]), z[2] * fsigmoid(v0[2]), z[3] * fsigmoid(v0[3]), z[4] * fsigmoid(v1[0]), z[5] * fsigmoid(v1[1]), z[6] * fsigmoid(v1[2]), z[7] * fsigmoid(v1[3])};
                *(u32x4*)(Z + (size_t)(u.pm * 256 + trow) * 512 + cc) = pack8(o); }
        EPIB_END
    }
};
struct EpiMoe1 { static constexpr bool PERM = true, AFTER_DRAIN = false, SEG2 = false, MID = false;
    bf16* HH;
    __device__ __forceinline__ void operator()(AccRef acc, const Unit& u, int wr, int wc, int fr, int fq) const {
        const int ct = u.pn & 3;
        EPI_ROWS_BEGIN const size_t slot = (size_t)u.pm * 256 + trow;
        EPI_COLS_BEGIN
            u32x2 w; w.x = cvt_pk_bf16(fsilu(v0[0]) * v1[0], fsilu(v0[1]) * v1[1]); w.y = cvt_pk_bf16(fsilu(v0[2]) * v1[2], fsilu(v0[3]) * v1[3]);
            *(u32x2*)(HH + slot * 512 + ct * 128 + (cc >> 3) * 4) = w;
        EPI_END
    }
};
template <int PASS> struct EpiMoe2 { static constexpr bool PERM = true, AFTER_DRAIN = false, SEG2 = false, MID = false;
    const int* slot_row; const float* slot_w; bf16* xs_lat; float *xo_f32, *xo_ctx; const float* modl; bf16* T; float scale; int outf;
    __device__ __forceinline__ void operator()(AccRef acc, const Unit& u, int wr, int wc, int fr, int fq) const {
        const int ct = u.pn & 3, colb = ct * 256 + wc * 32 + 8 * fq;
        EPIB_BEGIN
            int tok[2]; float wgt[2];
#pragma unroll
            for (int mm = 0; mm < 2; ++mm) { const int slot = u.pm * 256 + ai * 128 + wr * 64 + (mh * 2 + mm) * 16 + fr; tok[mm] = slot_row[slot]; wgt[mm] = slot_w[slot] * scale; }
            if constexpr (PASS == 0) {
                EPIB_ITEMS if (tok[mm] >= 0) { const f32x4 v0 = acc[ai][bj][m][0] * wgt[mm], v1 = acc[ai][bj][m][1] * wgt[mm];
                    u32x4 w; w.x = cvt_pk_bf16(v0[0], v0[1]); w.y = cvt_pk_bf16(v0[2], v0[3]); w.z = cvt_pk_bf16(v1[0], v1[1]); w.w = cvt_pk_bf16(v1[2], v1[3]);
                    *(u32x4*)(T + (size_t)tok[mm] * DM + colb + bj * 128) = w; } }
            } else {
                f32x4 xa[4], xb[4], ga[4], gb[4]; u32x4 tr[4]; size_t eo[4]; bool ic[4];
                EPIB_ITEMS const int tk = tok[mm] < 0 ? 0 : tok[mm]; const int b = tk / RB, rr = tk - b * RB; const bool isctx = rr < CTX; ic[it4] = isctx;
                    eo[it4] = (isctx ? (size_t)(b * CTX + rr) : (size_t)(b * SEQ + rr - CTX)) * DM + colb + bj * 128;
                    const float* g2 = modl + (size_t)((isctx ? 8 : b) * 6 + 5) * DM + colb + bj * 128;
                    if (isctx) { xa[it4] = *(const f32x4*)(xo_ctx + eo[it4]); xb[it4] = *(const f32x4*)(xo_ctx + eo[it4] + 4); }
                    else { const u32x4 r = *(const u32x4*)(xs_lat + eo[it4]); xa[it4] = __builtin_bit_cast(f32x4, r); xb[it4] = xa[it4]; }
                    ga[it4] = *(const f32x4*)g2; gb[it4] = *(const f32x4*)(g2 + 4);
                    tr[it4] = *(const u32x4*)(T + (size_t)tk * DM + colb + bj * 128); EPIB_FENCE
                EPIB_ITEMS if (tok[mm] >= 0) { float t8[8]; unpack8(tr[it4], t8);
                    const f32x4 y0 = (f32x4){t8[0], t8[1], t8[2], t8[3]} + acc[ai][bj][m][0] * wgt[mm], y1 = (f32x4){t8[4], t8[5], t8[6], t8[7]} + acc[ai][bj][m][1] * wgt[mm];
                    f32x4 x0 = xa[it4], x1 = xb[it4];
                    if (!ic[it4]) { float x8[8]; unpack8(__builtin_bit_cast(u32x4, xa[it4]), x8); x0 = (f32x4){x8[0], x8[1], x8[2], x8[3]}; x1 = (f32x4){x8[4], x8[5], x8[6], x8[7]}; }
                    const f32x4 z0 = x0 + ga[it4] * y0, z1 = x1 + gb[it4] * y1;
                    if (ic[it4]) { *(f32x4*)(xo_ctx + eo[it4]) = z0; *(f32x4*)(xo_ctx + eo[it4] + 4) = z1; }
                    else if (outf) { *(f32x4*)(xo_f32 + eo[it4]) = z0; *(f32x4*)(xo_f32 + eo[it4] + 4) = z1; }
                    else { u32x4 w; w.x = cvt_pk_bf16(z0[0], z0[1]); w.y = cvt_pk_bf16(z0[2], z0[3]); w.z = cvt_pk_bf16(z1[0], z1[1]); w.w = cvt_pk_bf16(z1[2], z1[3]); *(u32x4*)(xs_lat + eo[it4]) = w; } } }
            }
        EPIB_END
    }
};

constexpr size_t al256(size_t x) { return (x + 255) & ~(size_t)255; }
constexpr size_t WS_CTL = 0, CTL_BYTES = 1u << 20;
constexpr size_t WS_MOD  = CTL_BYTES;                 constexpr size_t SZ_MOD  = 2ull * 9 * 6 * DM * 4;
constexpr size_t WS_ROPE = WS_MOD + al256(SZ_MOD);    constexpr size_t SZ_ROPE = 2ull * SEQ * 32 * 4;
constexpr size_t WS_MISC = WS_ROPE + al256(SZ_ROPE);  constexpr size_t SZ_MISC = 8192;
constexpr size_t WS_POW  = WS_MISC + SZ_MISC;         constexpr size_t SZ_POW  = 2ull * 2 * 16 * 64 * 65 * 8;
constexpr size_t WS_BBAR = WS_POW + al256(SZ_POW);    constexpr size_t SZ_BBAR = 2ull * 2 * 16 * 64 * 16 * 8;
constexpr size_t WS_KC   = WS_BBAR + al256(SZ_BBAR);  constexpr size_t SZ_KC   = 2ull * 16 * 64 * 256 * 4;
constexpr size_t WS_ASG  = WS_KC + al256(SZ_KC);      constexpr size_t SZ_ASG  = 3ull * R * 2 * 4;
constexpr size_t WS_SLOT = WS_ASG + al256(SZ_ASG);    constexpr size_t SZ_SLOT = 2ull * NSLOT * 4;
constexpr size_t WS_TILE = WS_SLOT + al256(SZ_SLOT);  constexpr size_t SZ_TILE = 8192;
constexpr size_t WS_WIN  = WS_TILE + SZ_TILE;         constexpr size_t SZ_WIN  = 6144ull * 1024 * 2;
constexpr size_t WS_WOA  = WS_WIN + SZ_WIN;           constexpr size_t SZ_WOA  = 1024ull * 512 * 2;
constexpr size_t WS_WOS  = WS_WOA + SZ_WOA;           constexpr size_t SZ_WOS  = 1024ull * 256 * 2;
constexpr size_t WS_WOH  = WS_WOS + SZ_WOS;           constexpr size_t SZ_WOH  = 1024ull * 256 * 2;
constexpr size_t WS_WOUT = WS_WOH + SZ_WOH;           constexpr size_t SZ_WOUT = 1024ull * 1024 * 2;
constexpr size_t WS_WGLU = WS_WOUT + SZ_WOUT;         constexpr size_t SZ_WGLU = 256ull * 256 * 2;
constexpr size_t WS_WRT  = WS_WGLU + SZ_WGLU;         constexpr size_t SZ_WRT  = 256ull * 1024 * 2;
constexpr size_t WS_WGU  = WS_WRT + SZ_WRT;           constexpr size_t SZ_WGU  = 32ull * 1024 * 1024 * 2;
constexpr size_t WS_WDN  = WS_WGU + SZ_WGU;           constexpr size_t SZ_WDN  = 32ull * 1024 * 512 * 2;
constexpr size_t WS_WTOT = WS_WDN + SZ_WDN;           constexpr size_t SZ_WTOT = 16ull * 1024 * SLD * 2;
constexpr size_t WS_WE   = WS_WTOT + SZ_WTOT;         constexpr size_t SZ_WE   = 16ull * 256 * 1024 * 2;
constexpr size_t WS_RA   = WS_WE + SZ_WE;             constexpr size_t SZ_RA   = (size_t)R * 3072 * 2;
constexpr size_t OFF_Q = 0, OFF_K = (size_t)R * 512 * 2, OFF_V = 2 * OFF_K, OFF_H5 = 3 * OFF_K;
static_assert(OFF_H5 + 5ull * R * 256 * 2 <= SZ_RA && (size_t)NSLOT * 1024 * 2 <= SZ_RA, "region A");
constexpr size_t WS_HX   = WS_RA + SZ_RA;             constexpr size_t SZ_HX   = (size_t)R * 1024 * 2;
constexpr size_t WS_XS   = WS_HX + SZ_HX;             constexpr size_t SZ_Y    = (size_t)R * 1024 * 2;
constexpr size_t WS_Y    = 0;
static_assert(SZ_Y <= (size_t)NB * SEQ * DM * 4 && (size_t)NB * SEQ * DM * 2 <= SZ_Y, "y buffers fit d_out; the bf16 stream fits the old y region");
constexpr size_t OFF_YS = (size_t)R * 512 * 2, OFF_YH = OFF_YS + (size_t)R * 256 * 2;
static_assert(16ull * SROWS * SLD * 2 <= OFF_YS, "AG aliases y_att");
constexpr size_t WS_RB   = WS_XS + SZ_Y;              constexpr size_t SZ_RB   = (size_t)NSLOT * 512 * 2;
static_assert(64ull * NCH * 4096 * 4 <= SZ_RB && (size_t)R * 1024 * 2 <= SZ_RB, "region B");
constexpr size_t WS_E    = WS_RB + SZ_RB;             constexpr size_t SZ_E    = 16ull * NCHT * 256 * 4;
static_assert((size_t)R * 64 * 4 <= SZ_E, "router logits alias E");
constexpr size_t WS_DEC  = WS_E + SZ_E;               constexpr size_t SZ_DEC  = 64ull * NCH * 64 * 4;
constexpr size_t WS_CTXS = WS_DEC + al256(SZ_DEC);    constexpr size_t SZ_CTXS = (size_t)NB * CTX * DM * 4;
constexpr size_t WS_END  = WS_CTXS + SZ_CTXS;
static_assert(WS_END <= (1ull << 30), "workspace map exceeds 1 GiB");
constexpr int CW_BAR = 4096;
constexpr int CW_GCNT = 16384;

constexpr int RING_BYTES = 131072;
constexpr int MISC_OFF = RING_BYTES + 320;
constexpr int LDS_BYTES = 147456;
#define LDS_WAIT() asm volatile("s_waitcnt lgkmcnt(0)" ::: "memory")
#define VM_WAIT() asm volatile("s_waitcnt vmcnt(0)" ::: "memory")

#define XB_TMO      128
#define XB_XCNT(j)  (256  + 64 * (j))
#define XB_XSUB(j)  (1280 + 64 * (j))
#define XB_XGEN(j)  (2304 + 64 * (j))
#define XB_TOP      3328
#define XB_TOPGEN   3392
#define XCD_BAR_WORDS 3456
#define XB_SPIN_CAP (1u << 18)
__device__ __forceinline__ unsigned xb_ld(unsigned* p)              { return __hip_atomic_load(p, __ATOMIC_RELAXED, __HIP_MEMORY_SCOPE_AGENT); }
__device__ __forceinline__ unsigned xb_add(unsigned* p, unsigned v) { return __hip_atomic_fetch_add(p, v, __ATOMIC_RELAXED, __HIP_MEMORY_SCOPE_AGENT); }
__device__ __forceinline__ unsigned xb_xcc_id() { return (unsigned)__builtin_amdgcn_s_getreg((3 << 11) | 20) & 0xFu; }
#define XB_SPIN(cond, bar) do { unsigned _sp = 0; while (cond) { __builtin_amdgcn_s_sleep(1); \
    if ((++_sp & 255u) == 0u) { if (xb_ld(&(bar)[XB_TMO])) break; if (_sp > XB_SPIN_CAP) { atomicAdd(&(bar)[XB_TMO], 1u); break; } } } } while (0)
struct XcdBarrier { unsigned* bar; unsigned x; volatile LAS unsigned* st; };
__device__ __forceinline__ XcdBarrier xcd_barrier_post(unsigned* bar, volatile LAS unsigned* st, const int wv) {
    XcdBarrier b; b.bar = bar; b.x = xb_xcc_id(); b.st = st;
    if (wv == 0 && lane_id() == 0) (void)xb_add(&bar[XB_XCNT(b.x)], 1u);
    return b;
}
__device__ __forceinline__ void xcd_barrier_complete(unsigned* bar, unsigned x, unsigned& nloc, unsigned& nx) {
    const unsigned G = gridDim.x * gridDim.y * gridDim.z;
    unsigned sum, cnt, mine, sp = 0u;
    for (;;) {
        sum = 0u; cnt = 0u; mine = 0u;
#pragma unroll
        for (unsigned j = 0; j < 16; ++j) { const unsigned c = xb_ld(&bar[XB_XCNT(j)]); sum += c; cnt += (c > 0u) ? 1u : 0u; mine = (j == x) ? c : mine; }
        if (sum == G) break;
        __builtin_amdgcn_s_sleep(1);
        if ((++sp & 255u) == 0u) { if (xb_ld(&bar[XB_TMO])) break; if (sp > XB_SPIN_CAP) { atomicAdd(&bar[XB_TMO], 1u); break; } }
    }
    nloc = mine > 0u ? mine : 1u; nx = cnt > 0u ? cnt : 1u;
}
__device__ __forceinline__ void xcd_barrier(const XcdBarrier& b, const int wv) {
    asm volatile("s_waitcnt vmcnt(0)" ::: "memory");
    __syncthreads();
    if (wv == 0 && lane_id() == 0) {
        unsigned* bar = b.bar;
        __builtin_amdgcn_s_waitcnt(0);
        unsigned nloc = b.st[0], nx = b.st[1];
        if (nloc == 0u) { xcd_barrier_complete(bar, b.x, nloc, nx); b.st[0] = nloc; b.st[1] = nx; }
        const unsigned old = xb_add(&bar[XB_XSUB(b.x)], 1u);
        const unsigned gen = old / nloc;
        if (old + 1u == (gen + 1u) * nloc) {
            __builtin_amdgcn_fence(__ATOMIC_RELEASE, "agent");
            asm volatile("s_waitcnt vmcnt(0)" ::: "memory");
            const unsigned og = xb_add(&bar[XB_TOP], 1u);
            const unsigned tg = og / nx;
            if (og + 1u == (tg + 1u) * nx) xb_add(&bar[XB_TOPGEN], 1u);
            else XB_SPIN(xb_ld(&bar[XB_TOPGEN]) == tg, bar);
            __builtin_amdgcn_fence(__ATOMIC_ACQUIRE, "agent");
            xb_add(&bar[XB_XGEN(b.x)], 1u);
            asm volatile("s_waitcnt vmcnt(0)" ::: "memory");
        } else {
            XB_SPIN(xb_ld(&bar[XB_XGEN(b.x)]) == gen, bar);
            __builtin_amdgcn_fence(__ATOMIC_ACQUIRE, "agent");
            asm volatile("s_waitcnt vmcnt(0)" ::: "memory");
        }
    }
    __syncthreads();
}

__device__ __forceinline__ void ti_load(const float* W, int N, int item, int lane, float (&wv_)[32]);
template <class RM> __device__ __forceinline__ void ti_store(const float (&wv_)[32], int K, int N, bf16* WT, LAS float* scr, int item, int lane, RM rm, int ldw);
template <class RM> __device__ __forceinline__ void transpose_item(const float* W, int K, int N, bf16* WT, LAS float* scr, int item, int lane, RM rm, int ldw = 0) {
    float wv_[32];
    ti_load(W, N, item, lane, wv_);
    ti_store(wv_, K, N, WT, scr, item, lane, rm, ldw);
}
__device__ __forceinline__ void ti_load(const float* W, int N, int item, int lane, float (&wv_)[32]) {
    const int nblk = N / 32, kb = item / nblk, nb = item % nblk, k0 = 64 * kb, n0 = 32 * nb;
#pragma unroll
    for (int i = 0; i < 32; ++i) wv_[i] = W[(size_t)(k0 + 2 * i + (lane >> 5)) * N + n0 + (lane & 31)];
}
template <class RM> __device__ __forceinline__ void ti_store(const float (&wv_)[32], int K, int N, bf16* WT, LAS float* scr, int item, int lane, RM rm, int ldw) {
    if (ldw == 0) ldw = K;
    const int nblk = N / 32, kb = item / nblk, nb = item % nblk, k0 = 64 * kb, n0 = 32 * nb;
#pragma unroll
    for (int i = 0; i < 32; ++i) scr[(2 * i + (lane >> 5)) * 33 + (lane & 31)] = wv_[i];
    LDS_WAIT(); asm volatile("" ::: "memory");
    const int c = lane & 7;
#pragma unroll
    for (int j = 0; j < 4; ++j) { const int n = (lane >> 3) + 8 * j; const LAS float* s = scr + (8 * c) * 33 + n;
        u32x4 o; o.x = cvt_pk_bf16(s[0 * 33], s[1 * 33]); o.y = cvt_pk_bf16(s[2 * 33], s[3 * 33]); o.z = cvt_pk_bf16(s[4 * 33], s[5 * 33]); o.w = cvt_pk_bf16(s[6 * 33], s[7 * 33]);
        *(u32x4*)(WT + (size_t)rm(n0 + n) * ldw + k0 + 8 * c) = o; }
    LDS_WAIT(); asm volatile("" ::: "memory");
}
template <class RM> __device__ __forceinline__ void transpose_item_f8(const float* W, int K, int N, unsigned char* WT, LAS float* scr, int item, int lane, RM rm, float scl) {
    const int nblk = N / 32, kb = item / nblk, nb = item % nblk, k0 = 64 * kb, n0 = 32 * nb;
    float wv_[32];
#pragma unroll
    for (int i = 0; i < 32; ++i) wv_[i] = W[(size_t)(k0 + 2 * i + (lane >> 5)) * N + n0 + (lane & 31)];
#pragma unroll
    for (int i = 0; i < 32; ++i) scr[(2 * i + (lane >> 5)) * 33 + (lane & 31)] = wv_[i];
    LDS_WAIT(); asm volatile("" ::: "memory");
    const int c = lane & 7;
#pragma unroll
    for (int j = 0; j < 4; ++j) { const int n = (lane >> 3) + 8 * j; const LAS float* s = scr + (8 * c) * 33 + n;
        int lo = 0, hi = 0; lo = __builtin_amdgcn_cvt_pk_fp8_f32(s[0 * 33] * scl, s[1 * 33] * scl, lo, false); lo = __builtin_amdgcn_cvt_pk_fp8_f32(s[2 * 33] * scl, s[3 * 33] * scl, lo, true);
        hi = __builtin_amdgcn_cvt_pk_fp8_f32(s[4 * 33] * scl, s[5 * 33] * scl, hi, false); hi = __builtin_amdgcn_cvt_pk_fp8_f32(s[6 * 33] * scl, s[7 * 33] * scl, hi, true);
        *(u32x2*)(WT + (size_t)rm(n0 + n) * K + k0 + 8 * c) = (u32x2){(unsigned)lo, (unsigned)hi}; }
    LDS_WAIT(); asm volatile("" ::: "memory");
}
struct RmPlain { int off; __device__ __forceinline__ int operator()(int n) const { return off + n; } };
struct RmWin { __device__ __forceinline__ int operator()(int n) const {
    if (n >= 512 && n < 1024) { const int c = n - 512, sl = c >> 6, d = c & 63; return 512 + (sl >> 2) * 256 + ((d < 32) ? 32 * (sl & 3) + d : 128 + 32 * (sl & 3) + d - 32); }
    return (n >= 1024 && n < 1536) ? n + 1536 : (n >= 1536 && n < 3072) ? n - 512 : n; } };
struct RmGateUp { int add; __device__ __forceinline__ int operator()(int hid) const { return (hid >> 7) * 256 + ((hid & 127) >> 2) * 8 + (hid & 3) + add; } };

struct Ins { const float* p[36]; };
typedef const __attribute__((address_space(4))) Ins& InsK;
enum { I_X = 0, I_C, I_CTX, I_CCTX, I_ADAW, I_ADAB, I_NMIX, I_NFFN, I_WIN, I_QG, I_KG, I_DLAM, I_SUBLN, I_ARE, I_AIM, I_LOGDT, I_BRE, I_BIM, I_CRE, I_CIM, I_S5D, I_GLUW, I_GLUB,
       I_LB, I_HGN, I_WOA, I_WOS, I_WOH, I_WOUT, I_MWG, I_MBG, I_MWE, I_MBE, I_MGATE, I_MUP, I_MDOWN };

__device__ __forceinline__ void convert_weights(InsK in, unsigned char* ws, int l, LAS unsigned char* lds, int gw, int NGW, int wave, int lane) {
    LAS float* scr = (LAS float*)(lds + wave * 16384);
    constexpr int N_WIN = 16 * 192, N_WOA = 8 * 32, N_WOS = 4 * 32, N_WOUT = 16 * 32, N_GLU = 4 * 8, N_RTE = 16, N_RTG = 16, N_GU = 32 * 256, N_DN = 32 * 256;
    constexpr int TOTAL = N_WIN + N_WOA + 2 * N_WOS + N_WOUT + N_GLU + N_RTE + N_RTG + 2 * N_GU + N_DN;
    for (int it = gw; it < TOTAL - (2 * N_GU + N_DN); it += NGW) {
        int r = it;
        if (r < N_WIN) { transpose_item_f8(in.p[I_WIN] + (size_t)l * 1024 * 6144, 1024, 6144, ws + WS_WIN, scr, r, lane, RmWin{}, (r % 192 >= 96) ? -16.f * LOG2E : 16.f); continue; } r -= N_WIN;
        if (r < N_WOA) { transpose_item(in.p[I_WOA] + (size_t)l * 512 * 1024, 512, 1024, (bf16*)(ws + WS_WOA), scr, r, lane, RmPlain{0}, 1024); continue; } r -= N_WOA;
        if (r < N_WOS) { transpose_item(in.p[I_WOS] + (size_t)l * 256 * 1024, 256, 1024, (bf16*)(ws + WS_WOA) + 512, scr, r, lane, RmPlain{0}, 1024); continue; } r -= N_WOS;
        if (r < N_WOS) { transpose_item(in.p[I_WOH] + (size_t)l * 256 * 1024, 256, 1024, (bf16*)(ws + WS_WOA) + 768, scr, r, lane, RmPlain{0}, 1024); continue; } r -= N_WOS;
        if (r < N_WOUT) { transpose_item(in.p[I_WOUT] + (size_t)l * 1024 * 1024, 1024, 1024, (bf16*)(ws + WS_WOUT), scr, r, lane, RmPlain{0}); continue; } r -= N_WOUT;
        if (r < N_GLU) { transpose_item(in.p[I_GLUW] + (size_t)l * 256 * 256, 256, 256, (bf16*)(ws + WS_WGLU), scr, r, lane, RmPlain{0}); continue; } r -= N_GLU;
        if (r < N_RTE) { transpose_item(in.p[I_MWE] + (size_t)l * 1024 * 32, 1024, 32, (bf16*)(ws + WS_WRT), scr, r, lane, RmPlain{0}); continue; } r -= N_RTE;
        if (r < N_RTG) { const float* wg = in.p[I_MWG] + (size_t)l * 1024 * 4; bf16* wt = (bf16*)(ws + WS_WRT); const int k = r * 64 + lane;
#pragma unroll
            for (int g = 0; g < 4; ++g) wt[(size_t)(32 + g) * 1024 + k] = f2bf(wg[k * 4 + g]);
            continue; } r -= N_RTG;
    }
    constexpr int NE = 2 * N_GU + N_DN;
#define CW_SRC(r_) ((r_) < N_GU ? in.p[I_MGATE] + ((size_t)l * 32 + ((r_) >> 8)) * 1024 * 512 : (r_) < 2 * N_GU ? in.p[I_MUP] + ((size_t)l * 32 + (((r_) - N_GU) >> 8)) * 1024 * 512 : in.p[I_MDOWN] + ((size_t)l * 32 + (((r_) - 2 * N_GU) >> 8)) * 512 * 1024)
    int r = (gw + NGW - (TOTAL - NE) % NGW) % NGW;
    float cur_[32], nxt_[32];
    if (r < NE) ti_load(CW_SRC(r), r < 2 * N_GU ? 512 : 1024, r & 255, lane, cur_);
    while (r < NE) { const int rn = r + NGW, rl = rn < NE ? rn : r;
        ti_load(CW_SRC(rl), rl < 2 * N_GU ? 512 : 1024, rl & 255, lane, nxt_);
        if (r < N_GU) { const int e = r >> 8; ti_store(cur_, 1024, 512, (bf16*)(ws + WS_WGU) + (size_t)e * 1024 * 1024, scr, r & 255, lane, RmGateUp{0}, 0); }
        else if (r < 2 * N_GU) { const int e = (r - N_GU) >> 8; ti_store(cur_, 1024, 512, (bf16*)(ws + WS_WGU) + (size_t)e * 1024 * 1024, scr, r & 255, lane, RmGateUp{4}, 0); }
        else { const int e = (r - 2 * N_GU) >> 8; ti_store(cur_, 512, 1024, (bf16*)(ws + WS_WDN) + (size_t)e * 1024 * 512, scr, r & 255, lane, RmPlain{0}, 0); }
#pragma unroll
        for (int i = 0; i < 32; ++i) cur_[i] = nxt_[i];
        r = rn; }
#undef CW_SRC
}

__device__ __forceinline__ void norm_rows(const void* x_lat, int latbf  , const float* x_ctx, const float* gain, const float* modl, int which, bf16* HX, int gw, int NGW, int lane, bool f8out = false  ) {
    for (int row0 = gw; row0 < R; row0 += 2 * NGW) {
        f32x4 v[2][4]; const float* shp[2]; bool ok[2];
#pragma unroll
        for (int u = 0; u < 2; ++u) { const int row = row0 + u * NGW; ok[u] = row < R; const int rw = ok[u] ? row : row0; const int b = rw / RB, rr = rw - b * RB; const bool isctx = rr < CTX;
            shp[u] = modl + (size_t)((isctx ? 8 : b) * 6 + which * 3) * DM;
            if (!isctx && latbf) { const bf16* xr = (const bf16*)x_lat + (size_t)(b * SEQ + rr - CTX) * DM;
#pragma unroll
                for (int j = 0; j < 4; ++j) { const u32x2 r = *(const u32x2*)(xr + 256 * j + 4 * lane);
                    v[u][j] = (f32x4){__builtin_bit_cast(float, r.x << 16), __builtin_bit_cast(float, r.x & 0xffff0000u), __builtin_bit_cast(float, r.y << 16), __builtin_bit_cast(float, r.y & 0xffff0000u)}; } }
            else { const float* xr = isctx ? x_ctx + (size_t)(b * CTX + rr) * DM : (const float*)x_lat + (size_t)(b * SEQ + rr - CTX) * DM;
#pragma unroll
                for (int j = 0; j < 4; ++j) v[u][j] = *(const f32x4*)(xr + 256 * j + 4 * lane); } }
#pragma unroll
        for (int u = 0; u < 2; ++u) { float s = 0.f;
#pragma unroll
            for (int j = 0; j < 4; ++j) s += (v[u][j].x * v[u][j].x + v[u][j].y * v[u][j].y) + (v[u][j].z * v[u][j].z + v[u][j].w * v[u][j].w);
            const float rinv = __builtin_amdgcn_rsqf(wave_sum(s, lane) * (1.f / DM) + RMS_EPS);
            if (ok[u]) { const int row = row0 + u * NGW; const float* sh = shp[u]; const float* sc = sh + DM;
#pragma unroll
                for (int j = 0; j < 4; ++j) { const int c = 256 * j + 4 * lane; const f32x4 g = *(const f32x4*)(gain + c), a = *(const f32x4*)(sc + c), d = *(const f32x4*)(sh + c);
                    const f32x4 y = v[u][j] * rinv * g * (a + 1.f) + d;
                    if (f8out) { int w8 = 0; w8 = __builtin_amdgcn_cvt_pk_fp8_f32(y.x * 4.f, y.y * 4.f, w8, false); w8 = __builtin_amdgcn_cvt_pk_fp8_f32(y.z * 4.f, y.w * 4.f, w8, true); *(int*)((unsigned char*)HX + (size_t)row * DM + c) = w8; }
                    else { u32x2 w; w.x = cvt_pk_bf16(y.x, y.y); w.y = cvt_pk_bf16(y.z, y.w); *(u32x2*)(HX + (size_t)row * DM + c) = w; } } } }
    }
}

__device__ __forceinline__ void norm_mix(const void* x_lat, int latbf, const float* x_ctx, const float* gain, const float* modl, unsigned char* HX8, LAS unsigned char* lds, int vcu, int G, int wv, int tid, int lane) {
    const int r_lo = (int)((long long)vcu * R / G), r_hi = (int)((long long)(vcu + 1) * R / G);
    const int b_lo = r_lo / RB;
    for (int i = tid; i < 3 * 256; i += 512) { const int slot = i >> 8, c = i & 255; const int set = slot == 2 ? 8 : min(b_lo + slot, 7);
        const f32x4 g4 = *(const f32x4*)(gain + 4 * c), d4 = *(const f32x4*)(modl + (size_t)(set * 6 + 0) * DM + 4 * c), a4 = *(const f32x4*)(modl + (size_t)(set * 6 + 1) * DM + 4 * c);
        f32x4 gp4; gp4[0] = 4.f * (g4[0] * (a4[0] + 1.f)); gp4[1] = 4.f * (g4[1] * (a4[1] + 1.f)); gp4[2] = 4.f * (g4[2] * (a4[2] + 1.f)); gp4[3] = 4.f * (g4[3] * (a4[3] + 1.f));
        *(LAS f32x4*)(lds + slot * 8192 + c * 16) = gp4; *(LAS f32x4*)(lds + slot * 8192 + 4096 + c * 16) = d4 * 4.f; }
    __syncthreads();
    const int nrw = (r_hi - r_lo - wv + 7) >> 3;
    const int nit = (nrw + 3) >> 2;
    u32x4 cur[4][4], nxt[4][4];
#define NM_LOAD(buf, it_) { _Pragma("unroll") for (int u = 0; u < 4; ++u) { const int k_ = min(4 * (it_) + u, nrw - 1); const int row = r_lo + wv + 8 * k_; const int b = row / RB, rr = row - b * RB; const bool isctx = rr < CTX; \
        if (!isctx && latbf) { const bf16* xr = (const bf16*)x_lat + (size_t)(b * SEQ + rr - CTX) * DM + 4 * lane; _Pragma("unroll") for (int j = 0; j < 4; ++j) { const u32x2 r2 = *(const u32x2*)(xr + 256 * j); buf[u][j].x = r2.x; buf[u][j].y = r2.y; } } \
        else { const float* xr = (isctx ? x_ctx + (size_t)(b * CTX + rr) * DM : (const float*)x_lat + (size_t)(b * SEQ + rr - CTX) * DM) + 4 * lane; _Pragma("unroll") for (int j = 0; j < 4; ++j) buf[u][j] = *(const u32x4*)(xr + 256 * j); } } }
    if (nit > 0) NM_LOAD(cur, 0)
    for (int it = 0; it < nit; ++it) {
        NM_LOAD(nxt, min(it + 1, nit - 1))
#pragma unroll
        for (int u = 0; u < 4; ++u) { const int k = 4 * it + u; const int kc = min(k, nrw - 1); const int row = r_lo + wv + 8 * kc; const int b = row / RB, rr = row - b * RB; const bool isctx = rr < CTX;
            f32x4 v[4];
            if (!isctx && latbf) {
#pragma unroll
                for (int j = 0; j < 4; ++j) { const unsigned rx = cur[u][j].x, ry = cur[u][j].y; v[j] = (f32x4){__builtin_bit_cast(float, rx << 16), __builtin_bit_cast(float, rx & 0xffff0000u), __builtin_bit_cast(float, ry << 16), __builtin_bit_cast(float, ry & 0xffff0000u)}; } }
            else {
#pragma unroll
                for (int j = 0; j < 4; ++j) v[j] = __builtin_bit_cast(f32x4, cur[u][j]); }
            float sq = 0.f;
#pragma unroll
            for (int j = 0; j < 4; ++j) sq += (v[j].x * v[j].x + v[j].y * v[j].y) + (v[j].z * v[j].z + v[j].w * v[j].w);
            const float rinv = __builtin_amdgcn_rsqf(wave_sum(sq, lane) * (1.f / DM) + RMS_EPS);
            if (k < nrw) { const LAS unsigned char* pl = lds + (isctx ? 2 : b - b_lo) * 8192 + lane * 16;
#pragma unroll
                for (int j = 0; j < 4; ++j) { const f32x4 g = *(const LAS f32x4*)(pl + 4096 * 0 + 1024 * j), d = *(const LAS f32x4*)(pl + 4096 + 1024 * j);
                    const f32x4 y = v[j] * rinv * g + d;
                    int w8 = 0; w8 = __builtin_amdgcn_cvt_pk_fp8_f32(y.x, y.y, w8, false); w8 = __builtin_amdgcn_cvt_pk_fp8_f32(y.z, y.w, w8, true); *(int*)(HX8 + (size_t)row * DM + 256 * j + 4 * lane) = w8; } } }
#pragma unroll
        for (int u = 0; u < 4; ++u)
#pragma unroll
            for (int j = 0; j < 4; ++j) cur[u][j] = nxt[u][j];
    }
#undef NM_LOAD
}

__device__ __forceinline__ void norm_route(const bf16* x_lat, const float* x_ctx, const float* gain, const float* modl, bf16* HX, const bf16* WRT, const float* bE, const float* bG,
                                           int* asg_gid, int* asg_pos, float* asg_w, unsigned* gcnt, LAS unsigned char* lds, bool skip_ctx, int vcu, int G, int wv, int tid, int lane) {
    constexpr int WST = 2064;
    constexpr int POFF = 36 * WST;
    constexpr int SOFF = POFF + 3 * 8192;
    constexpr int COFF = SOFF + 8 * 2368;
    constexpr int IOFF = COFF + 512;
    constexpr int NGRP = R / 16;
    const int g_lo = (int)((long long)vcu * NGRP / G), g_hi = (int)((long long)(vcu + 1) * NGRP / G);
    const int b_lo = (g_lo * 16) / RB;
    LAS unsigned* lcnt = (LAS unsigned*)(lds + COFF); LAS unsigned* lbase = lcnt + 64; LAS unsigned* rinfo = (LAS unsigned*)(lds + IOFF);
    for (int i = tid; i < 36 * 128; i += 512) { const int row = i >> 7, ch = i & 127; *(LAS u32x4*)(lds + row * WST + ch * 16) = *(const u32x4*)(WRT + (size_t)row * 1024 + ch * 8); }
    for (int i = tid; i < 3 * 256; i += 512) { const int slot = i >> 8, c = i & 255; const int set = slot == 2 ? 8 : min(b_lo + slot, 7);
        const f32x4 g4 = *(const f32x4*)(gain + 4 * c), d4 = *(const f32x4*)(modl + (size_t)(set * 6 + 3) * DM + 4 * c), a4 = *(const f32x4*)(modl + (size_t)(set * 6 + 4) * DM + 4 * c);
        f32x4 gp4; gp4[0] = g4[0] * (a4[0] + 1.f); gp4[1] = g4[1] * (a4[1] + 1.f); gp4[2] = g4[2] * (a4[2] + 1.f); gp4[3] = g4[3] * (a4[3] + 1.f);
        *(LAS f32x4*)(lds + POFF + slot * 8192 + c * 16) = gp4; *(LAS f32x4*)(lds + POFF + slot * 8192 + 4096 + c * 16) = d4; }
    if (tid < 64) lcnt[tid] = 0u;
    __syncthreads();
    const int r16 = lane & 15, q = lane >> 4;
    LAS float* scr = (LAS float*)(lds + SOFF + wv * 2368);
    for (int gi = g_lo + wv; gi < g_hi; gi += 8) {
        const int row = gi * 16 + r16; const int b = row / RB, rr = row - b * RB; const bool isctx = rr < CTX;
        const int rl = (gi - g_lo) * 16 + lane;
        if (skip_ctx && isctx) { if (lane < 16) { int neg = -1; asm volatile("" : "+v"(neg)); asg_gid[(gi * 16 + lane) * 2] = neg; asg_gid[(gi * 16 + lane) * 2 + 1] = neg; rinfo[rl * 2] = 0u; } continue; }
        u32x4 raw[32];
        if (isctx) { const float* xr = x_ctx + (size_t)(b * CTX + rr) * DM + 8 * q;
#pragma unroll
            for (int s_ = 0; s_ < 32; ++s_) { const f32x4 a = *(const f32x4*)(xr + 32 * s_), c = *(const f32x4*)(xr + 32 * s_ + 4);
                raw[s_].x = cvt_pk_bf16(a[0], a[1]); raw[s_].y = cvt_pk_bf16(a[2], a[3]); raw[s_].z = cvt_pk_bf16(c[0], c[1]); raw[s_].w = cvt_pk_bf16(c[2], c[3]); if ((s_ & 7) == 7) __builtin_amdgcn_sched_barrier(0); } }
        else { const bf16* xr = x_lat + (size_t)(b * SEQ + rr - CTX) * DM + 8 * q;
#pragma unroll
            for (int s_ = 0; s_ < 32; ++s_) raw[s_] = *(const u32x4*)(xr + 32 * s_); }
        float ss = 0.f;
#pragma unroll
        for (int s_ = 0; s_ < 32; ++s_) { float t8[8]; unpack8(raw[s_], t8);
#pragma unroll
            for (int e = 0; e < 8; ++e) ss += t8[e] * t8[e]; }
        ss += shx(ss, 16, lane); ss += shx(ss, 32, lane);
#pragma unroll
        for (int s_ = 0; s_ < 32; ++s_) asm volatile("" : "+v"(raw[s_]));
        const float rinv = __builtin_amdgcn_rsqf(ss * (1.f / DM) + RMS_EPS);
        const LAS unsigned char* pl = lds + POFF + (isctx ? 2 : b - b_lo) * 8192 + q * 32;
        f32x4 acc[3] = {{0.f, 0.f, 0.f, 0.f}, {0.f, 0.f, 0.f, 0.f}, {0.f, 0.f, 0.f, 0.f}};
        const unsigned hoff = (unsigned)row * 2048u + 16u * (unsigned)q;
        const LAS unsigned char* wl = lds + r16 * WST + q * 16;
        const LAS unsigned char* wl2 = lds + (r16 < 4 ? 32 + r16 : r16) * WST + q * 16;
#pragma unroll
        for (int s_ = 0; s_ < 32; ++s_) { float t8[8], y[8]; unpack8(raw[s_], t8);
            const f32x4 g0 = *(const LAS f32x4*)(pl + 128 * s_), g1 = *(const LAS f32x4*)(pl + 128 * s_ + 16), d0 = *(const LAS f32x4*)(pl + 4096 + 128 * s_), d1 = *(const LAS f32x4*)(pl + 4096 + 128 * s_ + 16);
#pragma unroll
            for (int e = 0; e < 4; ++e) { y[e] = t8[e] * rinv * g0[e] + d0[e]; y[4 + e] = t8[4 + e] * rinv * g1[e] + d1[e]; }
            const u32x4 w = pack8(y); *(u32x4*)((unsigned char*)HX + (hoff + 64u * s_)) = w;
            const bf16x8 af = __builtin_bit_cast(bf16x8, w);
            const bf16x8 b0 = *(const LAS bf16x8*)(wl + s_ * 64), b1 = *(const LAS bf16x8*)(wl + 16 * WST + s_ * 64), b2 = *(const LAS bf16x8*)(wl2 + s_ * 64);
            acc[0] = __builtin_amdgcn_mfma_f32_16x16x32_bf16(af, b0, acc[0], 0, 0, 0); acc[1] = __builtin_amdgcn_mfma_f32_16x16x32_bf16(af, b1, acc[1], 0, 0, 0); acc[2] = __builtin_amdgcn_mfma_f32_16x16x32_bf16(af, b2, acc[2], 0, 0, 0);
            if (s_ & 1) __builtin_amdgcn_sched_barrier(0); }
#pragma unroll
        for (int i = 0; i < 4; ++i) { scr[(4 * q + i) * 37 + r16] = acc[0][i]; scr[(4 * q + i) * 37 + 16 + r16] = acc[1][i]; if (r16 < 4) scr[(4 * q + i) * 37 + 32 + r16] = acc[2][i]; }
        __builtin_amdgcn_fence(__ATOMIC_RELEASE, "wavefront"); __builtin_amdgcn_wave_barrier(); __builtin_amdgcn_fence(__ATOMIC_ACQUIRE, "wavefront");
        if (lane < 16) {
            const LAS float* lr = scr + lane * 37;
            const float lg[4] = {lr[32] + bG[0], lr[33] + bG[1], lr[34] + bG[2], lr[35] + bG[3]};
            int gs = 0; float gm = lg[0];
#pragma unroll
            for (int k = 1; k < 4; ++k) if (lg[k] > gm) { gm = lg[k]; gs = k; }
            float zs = 0.f;
#pragma unroll
            for (int k = 0; k < 4; ++k) zs += __expf(lg[k] - gm);
            const float pg = 1.f / zs;
            float le[8];
#pragma unroll
            for (int k = 0; k < 8; ++k) le[k] = lr[gs * 8 + k] + bE[gs * 8 + k];
            int i0 = 0; float m0 = le[0];
#pragma unroll
            for (int k = 1; k < 8; ++k) if (le[k] > m0) { m0 = le[k]; i0 = k; }
            int i1 = -1; float m1 = -3.0e38f;
#pragma unroll
            for (int k = 0; k < 8; ++k) if (k != i0 && le[k] > m1) { m1 = le[k]; i1 = k; }
            const float e1 = __expf(m1 - m0); const float w0 = pg / (1.f + e1), w1 = pg * e1 / (1.f + e1);
            const int gid0 = gs * 8 + i0, gid1 = 32 + gs * 8 + i1;
            const unsigned rk0 = __hip_atomic_fetch_add(&lcnt[gid0], 1u, __ATOMIC_RELAXED, __HIP_MEMORY_SCOPE_WORKGROUP);
            const unsigned rk1 = __hip_atomic_fetch_add(&lcnt[gid1], 1u, __ATOMIC_RELAXED, __HIP_MEMORY_SCOPE_WORKGROUP);
            const int rowg = gi * 16 + lane;
            asg_gid[rowg * 2] = gid0; asg_gid[rowg * 2 + 1] = gid1; asg_w[rowg * 2] = w0; asg_w[rowg * 2 + 1] = w1;
            rinfo[rl * 2] = 0x10000u | (unsigned)gid0 | ((unsigned)gid1 << 8); rinfo[rl * 2 + 1] = rk0 | (rk1 << 16);
        }
        __builtin_amdgcn_wave_barrier();
    }
    __syncthreads();
    if (tid < 64) { const unsigned n = lcnt[tid]; lbase[tid] = n ? __hip_atomic_fetch_add(&gcnt[tid], n, __ATOMIC_RELAXED, __HIP_MEMORY_SCOPE_AGENT) : 0u; }
    __syncthreads();
    for (int rl = tid; rl < (g_hi - g_lo) * 16; rl += 512) { const unsigned i0 = rinfo[rl * 2], i1 = rinfo[rl * 2 + 1];
        if (i0 & 0x10000u) { const int rowg = g_lo * 16 + rl; asg_pos[rowg * 2] = (int)(lbase[i0 & 63u] + (i1 & 0xffffu)); asg_pos[rowg * 2 + 1] = (int)(lbase[(i0 >> 8) & 63u] + (i1 >> 16)); } }
}

__device__ __forceinline__ void mod_vectors(InsK in, float* MOD, LAS unsigned char* lds, int G, int tid, int wave, int lane) {
    LAS float* cact = (LAS float*)lds;
    LAS float* part = (LAS float*)(lds + 9 * 1024 * 4);
    for (int i = tid; i < 9 * 1024; i += 512) { const int bi = i >> 10, k = i & 1023; const float c = bi < 8 ? in.p[I_C][bi * 1024 + k] : in.p[I_CCTX][k]; cact[i] = fsilu(c); }
    __syncthreads();
    for (int u = blockIdx.x; u < 2 * 96; u += G) {
        const int l = u / 96, col = (u - l * 96) * 64 + lane;
        const float* w = in.p[I_ADAW] + (size_t)l * 1024 * 6144 + col;
        float acc[9];
#pragma unroll
        for (int bi = 0; bi < 9; ++bi) acc[bi] = 0.f;
        for (int k = wave * 128; k < wave * 128 + 128; ++k) { const float wv = w[(size_t)k * 6144];
#pragma unroll
            for (int bi = 0; bi < 9; ++bi) acc[bi] += cact[bi * 1024 + k] * wv; }
#pragma unroll
        for (int bi = 0; bi < 9; ++bi) part[(wave * 9 + bi) * 64 + lane] = acc[bi];
        __syncthreads();
        for (int i = tid; i < 9 * 64; i += 512) { const int bi = i >> 6, c = i & 63; float s = 0.f;
#pragma unroll
            for (int w8 = 0; w8 < 8; ++w8) s += part[(w8 * 9 + bi) * 64 + c];
            const int cg = (u - l * 96) * 64 + c; MOD[((size_t)l * 9 + bi) * 6144 + cg] = s + in.p[I_ADAB][l * 6144 + cg]; }
        __syncthreads();
    }
}
__device__ __forceinline__ void small_tables(InsK in, unsigned char* ws, int gtid, int NT) {
    float* rope = (float*)(ws + WS_ROPE);
    for (int i = gtid; i < SEQ * 32; i += NT) { const int t = i >> 5, a = i & 31; const float inv = powf(10000.f, -(float)(a & 15) / 16.f);
        const float ang = (float)(a < 16 ? (t >> 6) : (t & 63)) * inv; rope[i] = cosf(ang); rope[SEQ * 32 + i] = sinf(ang); }
    float* misc = (float*)(ws + WS_MISC);
    for (int i = gtid; i < 2 * 256; i += NT) { const float a0 = in.p[I_LB][i], a1 = in.p[I_LB][512 + i]; const float mx = fmaxf(a0, a1), e0 = expf(a0 - mx), e1 = expf(a1 - mx);
        misc[i] = 0.f; misc[512 + i] = e1 / (e0 + e1); }
    if (gtid < 2) { const int l = gtid; const float* lv = in.p[I_DLAM] + l * 256; float s01 = 0.f, s23 = 0.f;
        for (int k = 0; k < 64; ++k) { s01 += lv[k] * lv[64 + k]; s23 += lv[128 + k] * lv[192 + k]; }
        const float lam_init = 0.8f - 0.6f * expf(-0.3f * (float)l); misc[1024 + l] = expf(s01) - expf(s23) + lam_init; misc[1026 + l] = lam_init; }
    float* POW = (float*)(ws + WS_POW); float* BB = (float*)(ws + WS_BBAR);
    for (int i = gtid; i < 2 * 2 * 16 * 64 * 65; i += NT) { const int n = i % 65, q = i / 65, p = q & 63, g = (q >> 6) & 15, d = (q >> 10) & 1, l = q >> 11;
        const int ai = ((l * 2 + d) * 16 + g) * 64 + p; const double dt = exp((double)in.p[I_LOGDT][(l * 2 + d) * 16 + g]);
        const double are = (double)in.p[I_ARE][ai] * dt * n, aim = (double)in.p[I_AIM][ai] * dt * n, mag = exp(are);
        POW[2 * (size_t)i] = (float)(mag * cos(aim)); POW[2 * (size_t)i + 1] = (float)(mag * sin(aim)); }
    for (int i = gtid; i < 2 * 2 * 16 * 64; i += NT) { const int p = i & 63, g = (i >> 6) & 15, d = (i >> 10) & 1, l = i >> 11;
        const double dt = exp((double)in.p[I_LOGDT][(l * 2 + d) * 16 + g]), ar = in.p[I_ARE][i], aim = in.p[I_AIM][i];
        const double mag = exp(ar * dt), lr = mag * cos(aim * dt) - 1.0, li = mag * sin(aim * dt), den = ar * ar + aim * aim;
        const double cr = (lr * ar + li * aim) / den, ci = (li * ar - lr * aim) / den;
        const float* bre = in.p[I_BRE] + ((size_t)(l * 16 + g) * 64 + p) * 16; const float* bim = in.p[I_BIM] + ((size_t)(l * 16 + g) * 64 + p) * 16;
        for (int h = 0; h < 16; ++h) { const double br = bre[h], bi = bim[h]; BB[((size_t)i * 16 + h) * 2] = (float)(cr * br - ci * bi); BB[((size_t)i * 16 + h) * 2 + 1] = (float)(cr * bi + ci * br); } }
}
__device__ __forceinline__ void s5_compact(InsK in, unsigned char* ws, int l, LAS unsigned char* lds, int G, int tid) {
    LAS float* T = (LAS float*)lds;
    LAS float* Bs = (LAS float*)(lds + 16 * 64 * 2 * 4);
    const float* POW = (const float*)(ws + WS_POW); const float* BB = (const float*)(ws + WS_BBAR); float* KC = (float*)(ws + WS_KC);
    for (int it = blockIdx.x; it < 2 * 16 * 64; it += G) {
        const int n = it & 63, g = (it >> 6) & 15, d = it >> 10;
        for (int i = tid; i < 1024; i += 512) { const int hp = i >> 6, p = i & 63;
            const float cr = in.p[I_CRE][((size_t)(l * 16 + g) * 16 + hp) * 64 + p], ci = in.p[I_CIM][((size_t)(l * 16 + g) * 16 + hp) * 64 + p];
            const size_t pi = ((((size_t)(l * 2 + d) * 16 + g) * 64 + p) * 65 + n) * 2; const float pr = POW[pi], pim = POW[pi + 1];
            T[i * 2] = cr * pr - ci * pim; T[i * 2 + 1] = cr * pim + ci * pr; }
        for (int i = tid; i < 1024; i += 512) { const size_t bi = (((size_t)(l * 2 + d) * 16 + g) * 64) * 16 + i; Bs[i * 2] = BB[bi * 2]; Bs[i * 2 + 1] = BB[bi * 2 + 1]; }
        __syncthreads();
        if (tid < 256) { const int hp = tid >> 4, h = tid & 15; float s = 0.f;
            for (int p = 0; p < 64; ++p) { const float tr = T[(hp * 64 + p) * 2], ti = T[(hp * 64 + p) * 2 + 1], br = Bs[(p * 16 + h) * 2], bi = Bs[(p * 16 + h) * 2 + 1]; s += tr * br - ti * bi; }
            KC[(((size_t)d * 16 + g) * 64 + n) * 256 + tid] = s; }
        __syncthreads();
    }
}
__device__ __forceinline__ void s5_expand(InsK in, unsigned char* ws, int l, int gtid, int NT) {
    const float* POW = (const float*)(ws + WS_POW); const float* BB = (const float*)(ws + WS_BBAR); const float* KC = (const float*)(ws + WS_KC);
    bf16* WT = (bf16*)(ws + WS_WTOT); bf16* WE = (bf16*)(ws + WS_WE);
    for (int it = gtid; it < 16 * 1024 * (SLD / 8); it += NT) {
        const int k8 = it % (SLD / 8), q = it / (SLD / 8), nrow = q & 1023, g = q >> 10, j = nrow >> 4, hp = nrow & 15, k0 = k8 * 8;
        float o[8];
        if (k0 < 1024) { const int i = k0 >> 4, h0 = k0 & 15;
            const float* kf = KC + (((size_t)0 * 16 + g) * 64) * 256 + hp * 16 + h0; const float* kb = KC + (((size_t)1 * 16 + g) * 64) * 256 + hp * 16 + h0;
#pragma unroll
            for (int e = 0; e < 8; ++e) o[e] = i < j ? kf[(size_t)(j - i) * 256 + e] : (i > j ? kb[(size_t)(i - j) * 256 + e] : kf[e] + kb[e]);
        } else { const int d = (k0 >= 1152) ? 1 : 0, kk = k0 - 1024 - d * 128, n = d ? 64 - j : j + 1;
#pragma unroll
            for (int e = 0; e < 8; e += 2) { const int p = (kk + e) >> 1;
                const float cr = in.p[I_CRE][((size_t)(l * 16 + g) * 16 + hp) * 64 + p], ci = in.p[I_CIM][((size_t)(l * 16 + g) * 16 + hp) * 64 + p];
                const size_t pi = ((((size_t)(l * 2 + d) * 16 + g) * 64 + p) * 65 + n) * 2; const float pr = POW[pi], pim = POW[pi + 1];
                o[e] = cr * pr - ci * pim; o[e + 1] = -(cr * pim + ci * pr); } }
        *(u32x4*)(WT + ((size_t)g * 1024 + nrow) * SLD + k0) = pack8(o);
    }
    for (int it = gtid; it < 16 * 256 * 128; it += NT) {
        const int k8 = it & 127, q = it >> 7, n = q & 255, g = q >> 8, d = n >> 7, p = (n & 127) >> 1, ri = n & 1, k0 = k8 * 8, i = k0 >> 4, h0 = k0 & 15;
        const int pw = d ? i : 63 - i; const size_t pi = ((((size_t)(l * 2 + d) * 16 + g) * 64 + p) * 65 + pw) * 2; const float pr = POW[pi], pim = POW[pi + 1];
        const float* bb = BB + ((((size_t)(l * 2 + d) * 16 + g) * 64 + p) * 16 + h0) * 2;
        float o[8];
#pragma unroll
        for (int e = 0; e < 8; ++e) { const float br = bb[2 * e], bi = bb[2 * e + 1]; o[e] = ri ? (pr * bi + pim * br) : (pr * br - pim * bi); }
        *(u32x4*)(WE + ((size_t)g * 256 + n) * 1024 + k0) = pack8(o);
    }
}

namespace att {
constexpr int SHM_V = 64 * 128 * 2, SHM_K = 64 * 128 * 2, SHM_V8 = 64 * 128, SHM_K8 = 64 * 128;
#define KSWZ(row, colB) ((row) * 256 + ((colB) ^ (((row) & 7) << 4)))
#define SBAR() __builtin_amdgcn_sched_barrier(0)
__device__ __forceinline__ int crow(int r, int hi) { return (r & 3) + 8 * (r >> 2) + 4 * hi; }
__device__ __forceinline__ void exp_half(f32x16& p) {
#pragma unroll
    for (int r = 0; r < 16; ++r) p[r] = __builtin_amdgcn_exp2f(p[r]);
}
typedef int v8i __attribute__((ext_vector_type(8)));
__device__ __forceinline__ int pk_u8x4(const f32x16& p, int base) { unsigned w = __builtin_bit_cast(unsigned, p[base + 1]);
    w = __builtin_amdgcn_cvt_pk_u8_f32(p[base], 0, w); w = __builtin_amdgcn_cvt_pk_u8_f32(p[base + 1], 1, w); w = __builtin_amdgcn_cvt_pk_u8_f32(p[base + 2], 2, w); w = __builtin_amdgcn_cvt_pk_u8_f32(p[base + 3], 3, w); return (int)w; }
template <int Q> __device__ __forceinline__ void sm_quarter(const f32x16& p0, int (&nb)[4]) { nb[Q] = pk_u8x4(p0, 4 * Q); }
__device__ __forceinline__ v8i finishSM2(const f32x16& p1, const int (&nb)[4]) {
    return v8i{nb[0], nb[1], nb[2], nb[3], pk_u8x4(p1, 0), pk_u8x4(p1, 4), pk_u8x4(p1, 8), pk_u8x4(p1, 12)};
}
__device__ __forceinline__ void qkt(f32x16& p0, f32x16& p1, const LAS char* Ks, const bf16x8* qr, int mapoff, int r32, int hi) {
    p0 = f32x16{}; p1 = f32x16{};
#pragma unroll
    for (int d0 = 0; d0 < 4; ++d0) { const int cb = (mapoff + d0 * 16 + hi * 8) * 2;
        const bf16x8 b0 = *reinterpret_cast<const LAS bf16x8*>(Ks + KSWZ(r32, cb));
        const bf16x8 b1 = *reinterpret_cast<const LAS bf16x8*>(Ks + KSWZ(32 + r32, cb));
        p0 = __builtin_amdgcn_mfma_f32_32x32x16_bf16(b0, qr[d0], p0, 0, 0, 0);
        p1 = __builtin_amdgcn_mfma_f32_32x32x16_bf16(b1, qr[d0], p1, 0, 0, 0); }
}
template <int G> __device__ __forceinline__ void kload1(u32x4* kq, const LAS char* Ks, int map, int r32, int hi) {
    const int row = r32 + 32 * (G >> 1), c = map * 4 + 2 * hi + (G & 1);
    kq[G] = *reinterpret_cast<const LAS u32x4*>(Ks + row * 128 + ((c ^ ((r32 >> 1) & 7)) << 4));
}
__device__ __forceinline__ void qk_mma(f32x16& p0, f32x16& p1, const u32x4* kq, const v8i q8, const f32x16& m5) {
    const v8i ka = {(int)kq[0].x, (int)kq[0].y, (int)kq[0].z, (int)kq[0].w, (int)kq[1].x, (int)kq[1].y, (int)kq[1].z, (int)kq[1].w};
    const v8i kb = {(int)kq[2].x, (int)kq[2].y, (int)kq[2].z, (int)kq[2].w, (int)kq[3].x, (int)kq[3].y, (int)kq[3].z, (int)kq[3].w};
    p0 = __builtin_amdgcn_mfma_scale_f32_32x32x64_f8f6f4(ka, q8, m5, 0, 0, 0, 0x7f7f7f7f, 0, (int)0x80808080u);
    p1 = __builtin_amdgcn_mfma_scale_f32_32x32x64_f8f6f4(kb, q8, m5, 0, 0, 0, 0x7f7f7f7f, 0, (int)0x80808080u);
}
struct VB { const LAS char *p0, *p1; };
__device__ __forceinline__ VB v_rd_bases(const LAS char* Vt, int lane) { const int r = lane & 31, hi = lane >> 5, sw = (r >> 2) & 3; const LAS char* b = Vt + r * 64;
    return VB{b + (((2 * hi) ^ sw) << 4), b + (((2 * hi + 1) ^ sw) << 4)}; }
struct AF { u32x4 lo, hi; };
template <int D0> __device__ __forceinline__ AF pv_load(const VB vb) { return AF{*(const LAS u32x4*)(vb.p0 + D0 * 2048), *(const LAS u32x4*)(vb.p1 + D0 * 2048)}; }
__device__ __forceinline__ void pv_mma(f32x16& od, const AF& f, const v8i pb) {
    const v8i a = {(int)f.lo.x, (int)f.lo.y, (int)f.lo.z, (int)f.lo.w, (int)f.hi.x, (int)f.hi.y, (int)f.hi.z, (int)f.hi.w};
    od = __builtin_amdgcn_mfma_scale_f32_32x32x64_f8f6f4(a, pb, od, 0, 0, 0, 0x7f7f7f7f, 0, 0x7f7f7f7f);
}
__device__ __forceinline__ void pv_ones(f32x16& ol, const v8i ones8, const v8i pb) { ol = __builtin_amdgcn_mfma_scale_f32_32x32x64_f8f6f4(ones8, pb, ol, 0, 0, 0, 0x7f7f7f7f, 0, 0x7f7f7f7f); }
__device__ __forceinline__ void pv_d0k(f32x16* o, f32x16& ol, const v8i ones8, const VB vb, const v8i pb, u32x4* kf, const LAS char* Ks, int mapoff, int r32, int hi, f32x16& y0, int (&nb)[4]) {
    const AF f0 = pv_load<0>(vb); SBAR();
    const AF f1 = pv_load<1>(vb); SBAR(); kload1<0>(kf, Ks, mapoff, r32, hi); sm_quarter<0>(y0, nb); pv_mma(o[0], f0, pb); SBAR();
    const AF f2 = pv_load<2>(vb); SBAR(); kload1<1>(kf, Ks, mapoff, r32, hi); sm_quarter<1>(y0, nb); pv_mma(o[1], f1, pb); SBAR();
    const AF f3 = pv_load<3>(vb); SBAR(); kload1<2>(kf, Ks, mapoff, r32, hi); sm_quarter<2>(y0, nb); pv_mma(o[2], f2, pb); pv_ones(ol, ones8, pb); SBAR();
    kload1<3>(kf, Ks, mapoff, r32, hi); sm_quarter<3>(y0, nb); pv_mma(o[3], f3, pb);
}
__device__ __forceinline__ void pv_d0(f32x16* o, f32x16& ol, const v8i ones8, const VB vb, const v8i pb) {
    const AF f0 = pv_load<0>(vb), f1 = pv_load<1>(vb); SBAR(); pv_mma(o[0], f0, pb); pv_ones(ol, ones8, pb);
    const AF f2 = pv_load<2>(vb); SBAR(); pv_mma(o[1], f1, pb);
    const AF f3 = pv_load<3>(vb); SBAR(); pv_mma(o[2], f2, pb); pv_mma(o[3], f3, pb);
}
__device__ __forceinline__ void diff_attn_unit(const bf16* __restrict__ Qb, const unsigned char* __restrict__ Kh, const unsigned char* __restrict__ Vh, bf16* __restrict__ Yb, int seq,
                                               float lam, float oscale, const float* __restrict__ subg, const float* __restrict__ qg, const float* __restrict__ rope, int qt0  , LAS char* lds, const int wv) {
    int lane_ = lane_id(); asm volatile("" : "+v"(lane_)); const int lane = lane_, wid = wv, tid = wv * 64 + lane, r32 = lane & 31, hi = lane >> 5, qblk = wid & 3, map = wid >> 2;
    LAS char* V_lds = lds; LAS char* K_lds = lds + 2 * SHM_V;
    f32x16 o[4] = {}, ol = {}; v8i q8;
    const int skk = tid >> 3, skc = tid & 7, kst0 = skk * 128 + ((skc ^ ((skk >> 1) & 7)) << 4);
    const int vdv = tid >> 2, vkc = tid & 3, vst0 = vdv * 64 + ((vkc ^ ((vdv >> 2) & 3)) << 4);
    const VB vbA = v_rd_bases(V_lds, lane), vbB = v_rd_bases(V_lds + SHM_V8, lane);
    f32x16 m5; { float tq = 0.75f; asm volatile("" : "+v"(tq)); float t5 = (__builtin_amdgcn_cvt_pk_u8_f32(tq, 0, 0u) & 255u) ? 8.f : 8.5f;
        asm volatile("" : "+v"(t5));
#pragma unroll
        for (int r = 0; r < 16; ++r) m5[r] = t5; }
    asm volatile("" : "+v"(m5));
    v8i ones8; { int t1 = 0x38383838; asm volatile("" : "+v"(t1));
#pragma unroll
        for (int r = 0; r < 8; ++r) ones8[r] = t1; }
    asm volatile("" : "+v"(ones8));
    const int mapoff = map;
    struct { bf16x8 vs0, ks0; } sr_[2];
    const unsigned go0 = (unsigned)(skk * 512 + skc * 16);
    const unsigned gv0 = (unsigned)(vdv * RB + vkc * 16);
    const __amdgpu_buffer_rsrc_t rsK = __builtin_amdgcn_make_buffer_rsrc((void*)Kh, (short)0, seq * 512, 0x00020000), rsV = __builtin_amdgcn_make_buffer_rsrc((void*)Vh, (short)0, 128 * RB, 0x00020000);
#define BLD(rs, vo, so) __builtin_bit_cast(bf16x8, __builtin_amdgcn_raw_buffer_load_b128(rs, (int)(vo), (int)(so), 0))
#define VLOAD(i, k0) do { sr_[i].vs0 = BLD(rsV, gv0, (k0)); } while (0)
#define KLOAD(i, k0) do { sr_[i].ks0 = BLD(rsK, go0, (k0) * 512); } while (0)
#define VWRITE(b, i) do { *(LAS bf16x8*)(V_lds + (b) * SHM_V8 + vst0) = sr_[i].vs0; } while (0)
#define KWRITE(b, i) do { *(LAS bf16x8*)(K_lds + (b) * SHM_K8 + kst0) = sr_[i].ks0; } while (0)
#define TCL(t) ((t) * 64)
#define KLOADF(Ks) do { kload1<0>(kf, Ks, mapoff, r32, hi); kload1<1>(kf, Ks, mapoff, r32, hi); kload1<2>(kf, Ks, mapoff, r32, hi); kload1<3>(kf, Ks, mapoff, r32, hi); } while (0)
    f32x16 pA0, pA1, pB0, pB1; u32x4 kf[4]; int nA[4], nB[4]; v8i pb; const int NT = seq / 64;
    VLOAD(0, 0); KLOAD(0, 0); KLOAD(1, TCL(1));
    const bf16x8 k2a = BLD(rsK, go0, TCL(2) * 512);
    SBAR();
    const bf16* Qw = Qb + (size_t)(qblk * 32 + r32) * 512 + map * 64 + hi * 8;
    {
        float qf[4][8]; float ss = 0.f;
#pragma unroll
        for (int d0 = 0; d0 < 4; ++d0) { const u32x4 raw = *reinterpret_cast<const u32x4*>(Qw + d0 * 16); unpack8(raw, qf[d0]);
#pragma unroll
            for (int j = 0; j < 8; ++j) ss += qf[d0][j] * qf[d0][j]; }
        { auto rr = __builtin_amdgcn_permlane32_swap(__float_as_uint(ss), __float_as_uint(ss), false, false); ss = __uint_as_float(rr[0]) + __uint_as_float(rr[1]); }
        const float rinv = __builtin_amdgcn_rsqf(ss * (1.f / 64.f) + RMS_EPS) * (0.125f * LOG2E);
#pragma unroll
        for (int d0 = 0; d0 < 4; ++d0) { const f32x4 ga = *(const f32x4*)(qg + d0 * 16 + hi * 8), gb = *(const f32x4*)(qg + d0 * 16 + hi * 8 + 4);
#pragma unroll
            for (int j = 0; j < 8; ++j) qf[d0][j] *= rinv * (j < 4 ? ga[j & 3] : gb[j & 3]); }
        if (qt0 >= 0) { const float* cs = rope + (size_t)(qt0 + qblk * 32 + r32) * 32 + hi * 8; const float* sn = cs + (size_t)SEQ * 32;
#pragma unroll
            for (int d0 = 0; d0 < 2; ++d0) { const f32x4 ca = *(const f32x4*)(cs + d0 * 16), cb = *(const f32x4*)(cs + d0 * 16 + 4), sa = *(const f32x4*)(sn + d0 * 16), sb = *(const f32x4*)(sn + d0 * 16 + 4);
#pragma unroll
                for (int j = 0; j < 8; ++j) { const float c = j < 4 ? ca[j & 3] : cb[j & 3], s = j < 4 ? sa[j & 3] : sb[j & 3], t1 = qf[d0][j], t2 = qf[d0 + 2][j]; qf[d0][j] = t1 * c - t2 * s; qf[d0 + 2][j] = t1 * s + t2 * c; } } }
#pragma unroll
        for (int d0 = 0; d0 < 4; ++d0) { int lo = 0, hi4 = 0;
            lo = __builtin_amdgcn_cvt_pk_fp8_f32(qf[d0][0] * 4.f, qf[d0][1] * 4.f, lo, false); lo = __builtin_amdgcn_cvt_pk_fp8_f32(qf[d0][2] * 4.f, qf[d0][3] * 4.f, lo, true);
            hi4 = __builtin_amdgcn_cvt_pk_fp8_f32(qf[d0][4] * 4.f, qf[d0][5] * 4.f, hi4, false); hi4 = __builtin_amdgcn_cvt_pk_fp8_f32(qf[d0][6] * 4.f, qf[d0][7] * 4.f, hi4, true);
            q8[2 * d0] = lo; q8[2 * d0 + 1] = hi4; }
    }
    VWRITE(0, 0); KWRITE(0, 0); KWRITE(1, 1);
    __syncthreads();
    VLOAD(1, TCL(1)); KLOAD(1, TCL(3)); VLOAD(0, TCL(2)); KLOAD(0, TCL(4));
    KLOADF(K_lds); qk_mma(pA0, pA1, kf, q8, m5); sm_quarter<0>(pA0, nA); sm_quarter<1>(pA0, nA); sm_quarter<2>(pA0, nA); sm_quarter<3>(pA0, nA); SBAR(); KLOADF(K_lds + SHM_K8);
    __syncthreads();
    *(LAS bf16x8*)(K_lds + kst0) = k2a;
    __syncthreads();
#define HALF(j, X0, X1, XN, Y0, Y1, YN, PB) do { \
        SBAR(); VWRITE(PB, PB); KWRITE(PB, PB); VLOAD(PB, TCL((j) + 2)); KLOAD(PB, TCL((j) + 4)); SBAR(); \
        qk_mma(Y0, Y1, kf, q8, m5); pb = finishSM2(X1, XN); SBAR(); \
        pv_d0k(o, ol, ones8, (PB) ? vbA : vbB, pb, kf, K_lds + (1 - PB) * SHM_K8, mapoff, r32, hi, Y0, YN); \
        __syncthreads(); } while (0)
    for (int j = 1; j + 1 < NT; j += 2) {
        HALF(j, pA0, pA1, nA, pB0, pB1, nB, 1);
        HALF(j + 1, pB0, pB1, nB, pA0, pA1, nA, 0);
    }
    HALF(NT - 1, pA0, pA1, nA, pB0, pB1, nB, 1);
    pb = finishSM2(pB1, nB); SBAR();
    pv_d0(o, ol, ones8, vbB, pb);
#undef HALF
#undef KLOADF
#undef TCL
#undef VLOAD
#undef BLD
#undef KLOAD
#undef VWRITE
#undef KWRITE
    const float rl = __builtin_amdgcn_rcpf(ol[0]);
    __syncthreads();
    LAS float* X = (LAS float*)lds + (size_t)qblk * 4096;
    if (map == 1) { const float sc1 = rl * lam;
#pragma unroll
        for (int d0 = 0; d0 < 4; ++d0)
#pragma unroll
            for (int r = 0; r < 16; ++r) X[(d0 * 16 + r) * 64 + lane] = o[d0][r] * sc1;
    }
    __syncthreads();
    if (map == 0) {
        float ssq = 0.f;
#pragma unroll
        for (int d0 = 0; d0 < 4; ++d0)
#pragma unroll
            for (int r = 0; r < 16; ++r) { const float v = o[d0][r] * rl - X[(d0 * 16 + r) * 64 + lane]; o[d0][r] = v; ssq += v * v; }
        { auto rr = __builtin_amdgcn_permlane32_swap(__float_as_uint(ssq), __float_as_uint(ssq), false, false); ssq = __uint_as_float(rr[0]) + __uint_as_float(rr[1]); }
        const float rn = __builtin_amdgcn_rsqf(ssq * (1.f / 128.f) + RMS_EPS) * oscale;
        bf16* Yw = Yb + (size_t)(qblk * 32 + r32) * 512 + 4 * hi;
#pragma unroll
        for (int d0 = 0; d0 < 4; ++d0)
#pragma unroll
            for (int g = 0; g < 4; ++g) { const f32x4 gs = *(const f32x4*)(subg + d0 * 32 + g * 8 + 4 * hi);
                u32x2 w; w.x = cvt_pk_bf16(o[d0][4 * g] * rn * gs[0], o[d0][4 * g + 1] * rn * gs[1]); w.y = cvt_pk_bf16(o[d0][4 * g + 2] * rn * gs[2], o[d0][4 * g + 3] * rn * gs[3]);
                *(u32x2*)(Yw + d0 * 32 + g * 8) = w; }
    }
    __syncthreads();
}
#undef KSWZ
#undef PK4
}

namespace hg {
constexpr int TS = 72;
constexpr int TILE_B = 64 * TS * 2;
constexpr int DIR_B = 49152;
constexpr int OUT_OFF = 98304;
__device__ __forceinline__ float clampf(float x, float lo, float hi) { return fminf(fmaxf(x, lo), hi); }
__device__ __forceinline__ f32x4 mm16(const LAS bf16* X, int mb, const LAS bf16* Y, int nb, f32x4 acc, int lane) {
    const int r = lane & 15, kq = (lane >> 4) * 8;
#pragma unroll
    for (int ks = 0; ks < 2; ++ks) { const bf16x8 a = *(const LAS bf16x8*)(X + (mb * 16 + r) * TS + ks * 32 + kq), b = *(const LAS bf16x8*)(Y + (nb * 16 + r) * TS + ks * 32 + kq);
        acc = __builtin_amdgcn_mfma_f32_16x16x32_bf16(a, b, acc, 0, 0, 0); }
    return acc;
}
struct Raw { unsigned rf[16], rv[16], rq[16]; f32x4 sraw[4]; u32x4 graw; };
struct Ptrs { const bf16 *HQ, *HFF, *HFB, *HI, *HGt; };
template <int MODE> __device__ __forceinline__ void load_unit(Raw& P, int b, int c, int hh, const Ptrs& Q, const float* ST, const int wv, const int lane) {
    const int wid = wv, tid = wv * 64 + lane, d = wid >> 2, tq = wid & 3, k = lane;
    const size_t r0 = (size_t)b * RB + (size_t)c * 64; const int ch = hh * 64 + k; const bf16* HF = d ? Q.HFB : Q.HFF; const size_t chain = (size_t)((b * 4 + hh) * 2 + d);
#pragma unroll
    for (int i = 0; i < 16; ++i) { const int jp = tq * 16 + i, j = d ? 63 - jp : jp; const size_t gi = (r0 + j) * 256 + ch; P.rf[i] = HF[gi]; P.rv[i] = Q.HI[gi]; if constexpr (MODE == 1) P.rq[i] = Q.HQ[gi]; }
    if constexpr (MODE == 1) { const int t = tid & 255, v = t >> 2, k0 = (t & 3) * 16; const float* sp = ST + (chain * NCH + c) * 4096 + v * 64 + k0;
#pragma unroll
        for (int q4 = 0; q4 < 4; ++q4) P.sraw[q4] = *(const f32x4*)(sp + q4 * 4);
        P.graw = *(const u32x4*)(Q.HGt + (r0 + (tid >> 3)) * 256 + hh * 64 + (tid & 7) * 8); }
}
template <int MODE> __device__ __forceinline__ void unit(Raw& P, int b, int c, int hh, bool has_next, int nb, int nc, int nhh, const Ptrs& Q, const float* lower  ,
                                                          const float* norm_g, float* ST, float* DEC, bf16* YH, LAS unsigned char* lds, const int wv, const int lane) {
    const int wid = wv, tid = wv * 64 + lane, d = wid >> 2, w4 = wid & 3, k = lane, tq = w4;
    LAS unsigned char* base = lds + d * DIR_B;
    LAS bf16* T0 = (LAS bf16*)base; LAS bf16* T1 = (LAS bf16*)(base + TILE_B); LAS bf16* T2 = (LAS bf16*)(base + 2 * TILE_B); LAS bf16* T3 = (LAS bf16*)(base + 3 * TILE_B); LAS bf16* T4 = (LAS bf16*)(base + 4 * TILE_B);
    LAS float* TOT = (LAS float*)(base + 5 * TILE_B);
    const size_t r0 = (size_t)b * RB + (size_t)c * 64; const int ch = hh * 64 + k;
    const float lb = lower[d * 256 + ch];
    const size_t chain = (size_t)((b * 4 + hh) * 2 + d);
    float lf[16], kk[16], qv[16], vv[16];
    asm volatile("" ::: "memory");
    float run = 0.f;
#pragma unroll
    for (int i = 0; i < 16; ++i) {
        const float fz = bf2f((bf16)P.rf[i]);
        const float te = fexp(fminf(-fz, 80.f));
        const float sg = __builtin_amdgcn_rcpf(1.f + te);
        run += __logf(lb + (1.f - lb) * sg); lf[i] = run;
        kk[i] = (1.f - lb) * te * sg;
        vv[i] = bf2f((bf16)P.rv[i]);
        if constexpr (MODE == 1) qv[i] = fsilu(bf2f((bf16)P.rq[i])); }
    TOT[tq * 64 + k] = run;
    __syncthreads();
    const float t0 = TOT[k], t1 = TOT[64 + k], t2 = TOT[128 + k], t3 = TOT[192 + k];
    const float off = (tq > 0 ? t0 : 0.f) + (tq > 1 ? t1 : 0.f) + (tq > 2 ? t2 : 0.f), bL = (t0 + t1) + (t2 + t3), beta = t0 + t1;
    { float t8[8];
#pragma unroll
      for (int h8 = 0; h8 < 2; ++h8) {
#pragma unroll
        for (int e = 0; e < 8; ++e) t8[e] = vv[h8 * 8 + e];
        *(LAS u32x4*)(T4 + k * TS + tq * 16 + h8 * 8) = pack8(t8); } }
    if constexpr (MODE == 0) {
        { float t8[8];
#pragma unroll
          for (int h8 = 0; h8 < 2; ++h8) {
#pragma unroll
            for (int e = 0; e < 8; ++e) { const int i = h8 * 8 + e; t8[e] = kk[i] * fexp(bL - (off + lf[i])); }
            *(LAS u32x4*)(T1 + k * TS + tq * 16 + h8 * 8) = pack8(t8); } }
        if (tq == 0) DEC[(chain * NCH + c) * 64 + k] = fexp(bL);
        if (has_next) load_unit<MODE>(P, nb, nc, nhh, Q, ST, wv, lane);
        __syncthreads();
        f32x4 acc[4];
#pragma unroll
        for (int nb = 0; nb < 4; ++nb) acc[nb] = mm16(T4, w4, T1, nb, (f32x4){0.f, 0.f, 0.f, 0.f}, lane);
        float* sp = ST + (chain * NCH + c) * 4096;
#pragma unroll
        for (int nb = 0; nb < 4; ++nb)
#pragma unroll
            for (int rg = 0; rg < 4; ++rg) sp[(w4 * 16 + (lane >> 4) * 4 + rg) * 64 + nb * 16 + (lane & 15)] = acc[nb][rg];
        __syncthreads();
    } else {
#pragma unroll
        for (int i = 0; i < 16; ++i) { const int jp = tq * 16 + i; const float bj = off + lf[i];
            T0[jp * TS + k] = f2bf(qv[i] * fexp(clampf(bj - beta, -80.f, 80.f)));
            T1[jp * TS + k] = f2bf(kk[i] * fexp(clampf(beta - bj, -80.f, 80.f)));
            T2[jp * TS + k] = f2bf(qv[i] * fexp(bj)); }
        { const int t = tid & 255, v = t >> 2, k0 = (t & 3) * 16;
#pragma unroll
          for (int h8 = 0; h8 < 2; ++h8) { const f32x4 a = P.sraw[h8 * 2], bq = P.sraw[h8 * 2 + 1]; const float t8[8] = {a[0], a[1], a[2], a[3], bq[0], bq[1], bq[2], bq[3]};
            *(LAS u32x4*)(T3 + v * TS + k0 + h8 * 8) = pack8(t8); } }
        const u32x4 graw_cur = P.graw;
        if (has_next) load_unit<MODE>(P, nb, nc, nhh, Q, ST, wv, lane);
        __syncthreads();
        const int mb = w4;
        f32x4 accO[4], accA[4];
#pragma unroll
        for (int nb = 0; nb < 4; ++nb) { accO[nb] = mm16(T2, mb, T3, nb, (f32x4){0.f, 0.f, 0.f, 0.f}, lane);
            accA[nb] = (f32x4){0.f, 0.f, 0.f, 0.f}; if (nb <= mb) accA[nb] = mm16(T0, mb, T1, nb, accA[nb], lane); }
#pragma unroll
        for (int nb = 0; nb < 4; ++nb)
#pragma unroll
            for (int rg = 0; rg < 4; ++rg) { const int jr = mb * 16 + (lane >> 4) * 4 + rg, sc = nb * 16 + (lane & 15); T0[jr * TS + sc] = f2bf(sc <= jr ? accA[nb][rg] : 0.f); }
        LDS_WAIT();
#pragma unroll
        for (int nb = 0; nb < 4; ++nb) accO[nb] = mm16(T0, mb, T4, nb, accO[nb], lane);
        LAS float* OUT = (LAS float*)(lds + OUT_OFF + d * 16384);
#pragma unroll
        for (int nb = 0; nb < 4; ++nb)
#pragma unroll
            for (int rg = 0; rg < 4; ++rg) { const int jp = mb * 16 + (lane >> 4) * 4 + rg, tok = d ? 63 - jp : jp; OUT[tok * 64 + nb * 16 + (lane & 15)] = accO[nb][rg]; }
        __syncthreads();
        { const int j = tid >> 3, v0 = (tid & 7) * 8; const LAS float* o0 = (const LAS float*)(lds + OUT_OFF) + j * 64 + v0; const LAS float* o1 = o0 + 4096;
          float o[8], s = 0.f;
#pragma unroll
          for (int e = 0; e < 8; ++e) { o[e] = o0[e] + o1[e]; s += o[e] * o[e]; }
          s += shx(s, 1, lane); s += shx(s, 2, lane); s += shx(s, 4, lane);
          const float rinv = __builtin_amdgcn_rsqf(s * (1.f / 64.f) + RMS_EPS);
          const size_t gi = (r0 + j) * 512 + hh * 64 + v0; float gt[8]; unpack8(graw_cur, gt);
#pragma unroll
          for (int e = 0; e < 8; ++e) o[e] = o[e] * rinv * norm_g[v0 + e] * fsilu(gt[e]);
          *(u32x4*)(YH + gi) = pack8(o); }
        __syncthreads();
    }
}
__device__ __forceinline__ void carry(float* ST, const float* DEC, int G, int tid) {
    for (int u = blockIdx.x; u < 512; u += G) {
        const int chain = u >> 3, idx = (u & 7) * 512 + tid, kdec = idx & 63, d = chain & 1;
        float* sp = ST + (size_t)chain * NCH * 4096 + idx; const float* dp = DEC + (size_t)chain * NCH * 64 + kdec;
        float S = 0.f;
        static_assert(NCH % 33 == 0, "four batches of 33 chunk loads in flight per thread: enough bytes in flight to run at the HBM rate");
        for (int s0 = 0; s0 < NCH; s0 += 33) { float dl[33], dc[33];
#pragma unroll
            for (int q = 0; q < 33; ++q) { const int s = s0 + q; const int cq = d ? (s < 4 ? 3 - s : 135 - s) : s; dl[q] = sp[(size_t)cq * 4096]; dc[q] = dp[cq * 64]; }
#pragma unroll
            for (int q = 0; q < 33; ++q) { const int s = s0 + q; const int cq = d ? (s < 4 ? 3 - s : 135 - s) : s; sp[(size_t)cq * 4096] = S; S = dc[q] * S + dl[q]; } }
    }
}
}

__device__ __forceinline__ void s5_carry(const float* E, bf16* AG, const float* POW, int l, int gtid, int NT) {
    for (int i = gtid; i < NB * 16 * 2 * 64; i += NT) {
        const int p = i & 63, d = (i >> 6) & 1, g = (i >> 7) & 15, b = i >> 11;
        const size_t pi = ((((size_t)(l * 2 + d) * 16 + g) * 64 + p) * 65 + 64) * 2; const float lr = POW[pi], li = POW[pi + 1];
        float hr = 0.f, hi = 0.f;
        static_assert(NCH % 44 == 0, "three batches of 44 loads in flight: the chain is latency-bound");
        for (int s0 = 0; s0 < NCH; s0 += 44) { f32x2 ev[44];
#pragma unroll
            for (int q = 0; q < 44; ++q) { const int s = s0 + q; const int cq = d ? (s < 4 ? 3 - s : 135 - s) : s; ev[q] = *(const f32x2*)(E + ((size_t)(g * NCHT + b * NCH + cq)) * 256 + d * 128 + 2 * p); }
#pragma unroll
            for (int q = 0; q < 44; ++q) { const int s = s0 + q; const int cq = d ? (s < 4 ? 3 - s : 135 - s) : s; *(unsigned*)(AG + ((size_t)(g * SROWS + b * NCH + cq)) * SLD + 1024 + d * 128 + 2 * p) = cvt_pk_bf16(hr, hi);
                const float nr = lr * hr - li * hi + ev[q].x, ni = lr * hi + li * hr + ev[q].y; hr = nr; hi = ni; } }
    }
}

__device__ __forceinline__ void moe_route(const float* RT, const float* bE, const float* bG, bool skip_ctx, int* asg_gid, int* asg_pos, float* asg_w, unsigned* gcnt, LAS unsigned char* lds, int G, int tid) {
    LAS unsigned* lcnt = (LAS unsigned*)lds; LAS unsigned* lbase = lcnt + 64;
    for (int base = blockIdx.x * 512; base < R; base += G * 512) {
        if (tid < 64) lcnt[tid] = 0u;
        __syncthreads();
        const int row = base + tid; const int bb = row / RB; const bool valid = !(skip_ctx && (row - bb * RB) < CTX);
        int gid0 = -1, gid1 = -1; unsigned rk0 = 0u, rk1 = 0u; float w0 = 0.f, w1 = 0.f;
        if (valid) {
            const float* lr = RT + (size_t)row * 64;
            const f32x4 lgv = *(const f32x4*)(lr + 32); const float lg[4] = {lgv[0] + bG[0], lgv[1] + bG[1], lgv[2] + bG[2], lgv[3] + bG[3]};
            int gs = 0; float gm = lg[0];
#pragma unroll
            for (int q = 1; q < 4; ++q) if (lg[q] > gm) { gm = lg[q]; gs = q; }
            float zs = 0.f;
#pragma unroll
            for (int q = 0; q < 4; ++q) zs += __expf(lg[q] - gm);
            const float pg = 1.f / zs;
            const f32x4 ea = *(const f32x4*)(lr + gs * 8), eb = *(const f32x4*)(lr + gs * 8 + 4);
            float le[8] = {ea[0], ea[1], ea[2], ea[3], eb[0], eb[1], eb[2], eb[3]};
#pragma unroll
            for (int q = 0; q < 8; ++q) le[q] += bE[gs * 8 + q];
            int i0 = 0; float m0 = le[0];
#pragma unroll
            for (int q = 1; q < 8; ++q) if (le[q] > m0) { m0 = le[q]; i0 = q; }
            int i1 = -1; float m1 = -3.0e38f;
#pragma unroll
            for (int q = 0; q < 8; ++q) if (q != i0 && le[q] > m1) { m1 = le[q]; i1 = q; }
            const float e1 = __expf(m1 - m0); w0 = pg / (1.f + e1); w1 = pg * e1 / (1.f + e1);
            gid0 = gs * 8 + i0; gid1 = 32 + gs * 8 + i1;
            rk0 = __hip_atomic_fetch_add(&lcnt[gid0], 1u, __ATOMIC_RELAXED, __HIP_MEMORY_SCOPE_WORKGROUP);
            rk1 = __hip_atomic_fetch_add(&lcnt[gid1], 1u, __ATOMIC_RELAXED, __HIP_MEMORY_SCOPE_WORKGROUP);
        }
        __syncthreads();
        if (tid < 64) { const unsigned n = lcnt[tid]; lbase[tid] = n ? __hip_atomic_fetch_add(&gcnt[tid], n, __ATOMIC_RELAXED, __HIP_MEMORY_SCOPE_AGENT) : 0u; }
        __syncthreads();
        asg_gid[row * 2] = gid0; asg_gid[row * 2 + 1] = gid1;
        if (valid) { asg_pos[row * 2] = (int)(lbase[gid0] + rk0); asg_pos[row * 2 + 1] = (int)(lbase[gid1] + rk1); asg_w[row * 2] = w0; asg_w[row * 2 + 1] = w1; }
        __syncthreads();
    }
}
__device__ __forceinline__ void moe_scatter(const unsigned* gcnt, const int* asg_gid, const int* asg_pos, const float* asg_w, int* slot_row, float* slot_w, int* tile_tab, const bf16* HX, bf16* XG,
                                            LAS unsigned char* lds, int gw, int NGW, int tid, int lane) {
    LAS int* tstart = (LAS int*)lds;
    if (tid == 0) { int acc = 0;
        for (int g = 0; g < 64; ++g) { if (g == 32) tstart[64] = acc; tstart[g] = acc; acc += ((int)gcnt[g] + 255) >> 8; }
        tstart[65] = acc; }
    __syncthreads();
    if (blockIdx.x == 0) {
        if (tid < 64) { const int t0 = tstart[tid], t1 = (tid == 63) ? tstart[65] : tstart[tid + 1]; for (int t = t0; t < t1; ++t) tile_tab[t] = tid & 31; }
        if (tid == 0) { tile_tab[1024] = tstart[64]; tile_tab[1025] = tstart[65]; }
    }
    for (int a = gw * 64 + lane; a < 2 * R; a += NGW * 64) {
        const int gid = asg_gid[a]; if (gid < 0) continue;
        const int slot = tstart[gid] * 256 + asg_pos[a]; slot_row[slot] = a >> 1; slot_w[slot] = asg_w[a]; }
}

__device__ __forceinline__ int hg_next_unit(int u, int vcu, int bx, int G, int SKIP, int FULL) { const int cut = FULL * G; if (u < cut) { const int v = u + G; if (v < cut) return v; return bx >= SKIP ? cut + (bx - SKIP) : (1 << 30); } return u + (G - SKIP); }
constexpr int NPL = 16, NPHASE = 1 + 2 * NPL;
struct Args { Ins in; float* out; unsigned char* ws; int ph_lo, ph_hi; };
#define GEMM_CALL(EpiT, SchedT, g, S, E) pg8::gemm_phase<EpiT, SchedT, true, true>((PG8_LAS unsigned char*)lds, g, S, E, wv)
#ifndef COMP_MASK
#define COMP_MASK 0xFFFFFFFFu
#endif
#ifndef REP_MASK
#define REP_MASK 0u
#endif
#define C(n) ((COMP_MASK >> (n)) & 1u)
#define REPEAT(n) for (int rep_ = 0; rep_ <= (int)((REP_MASK >> (n)) & 1u); ++rep_)

typedef const __attribute__((address_space(4))) Args* KArgs;
__device__ __forceinline__ KArgs kargs() { KArgs p = (KArgs)__builtin_amdgcn_kernarg_segment_ptr(); asm volatile("" : "+s"(p)); return p; }

__global__ void __launch_bounds__(512, 2) hdt_fwd(Args args) {
    extern __shared__ __attribute__((aligned(16))) unsigned char lds_raw[];
    LAS unsigned char* lds = (LAS unsigned char*)lds_raw;
    volatile LAS unsigned* MISC = (volatile LAS unsigned*)(lds + MISC_OFF);
    const int wv = __builtin_amdgcn_readfirstlane((int)threadIdx.x >> 6);
#define ENV KArgs a_ = kargs(); unsigned char* const ws = a_->ws; InsK in = a_->in; float* const out = a_->out; const int G = gridDim.x, bx = blockIdx.x, vcu = (G % 8 == 0) ? (bx % 8) * (G / 8) + bx / 8 : bx; (void)in; (void)out; (void)vcu;
#define TID (wv * 64 + lane_id())
#define LANE (lane_id())
#define WAVE (wv)
#define GW (vcu * 8 + WAVE)
#define NGW (G * 8)
#define GTID (bx * 512 + TID)
#define NTH (G * 512)
    unsigned* ctl = (unsigned*)(args.ws + WS_CTL);
    for (int u = (int)threadIdx.x; u < (LDS_BYTES - RING_BYTES) / 4; u += 512) ((LAS unsigned*)(lds + RING_BYTES))[u] = 0u;
    __syncthreads();
    XcdBarrier bar = xcd_barrier_post(ctl + CW_BAR, MISC + 8, wv);
    const int lo = args.ph_lo, hi = args.ph_hi;
#define CTL ((unsigned*)(ws + WS_CTL))
#define IN(p) (lo <= (p) && (p) < hi)
#ifndef BAR_REP
#define BAR_REP 1
#endif
#define SEAM(p) do { if (lo <= (p) && (p) + 1 < hi) { for (int br_ = 0; br_ < BAR_REP; ++br_) xcd_barrier(bar, wv); } } while (0)
#define W_(off) (ws + (off))
    if (IN(0)) { ENV if (C(23)) REPEAT(23) { mod_vectors(in, (float*)W_(WS_MOD), lds, G, TID, WAVE, LANE); small_tables(in, ws, GTID, NTH); } }
    SEAM(0);

    for (int l = 0; l < 2; ++l) {
        const int P = 1 + l * NPL;
#define MODL ((const float*)W_(WS_MOD) + (size_t)l * 9 * 6144)
#define XIN_LAT (l ? (const void*)W_(WS_XS) : (const void*)in.p[I_X])
#define Y_(off) ((unsigned char*)out + (off))
#define XIN_CTX (l ? (const float*)W_(WS_CTXS) : in.p[I_CTX])
#define H5P ((bf16*)W_(WS_RA + OFF_H5))
        if (IN(P + 0)) { ENV if (C(0)) REPEAT(0) { convert_weights(in, ws, l, lds, GW, NGW, WAVE, LANE); __syncthreads();
            { int nl_ = lane_id(); asm volatile("" : "+v"(nl_)); norm_mix(XIN_LAT, l, XIN_CTX, in.p[I_NMIX] + l * DM, MODL, (unsigned char*)W_(WS_HX), lds, vcu, G, wv, wv * 64 + nl_, nl_); } __syncthreads();
            s5_compact(in, ws, l, lds, G, TID); } }
        SEAM(P + 0);
        if (IN(P + 1)) { ENV if (C(1)) REPEAT(1) s5_expand(in, ws, l, GTID, NTH);
            if (C(2)) REPEAT(2) { pg8::Gemm g{(const bf16*)W_(WS_HX), (const bf16*)W_(WS_WIN), R, 2560, 512, 512, 512};     pg8::StaticOrder S; S.init(R, 2560, G, bx);
                EpiInproj E{(bf16*)W_(WS_RA + OFF_Q), (bf16*)W_(WS_RA + OFF_K), H5P, (bf16*)Y_(0), in.p[I_KG] + l * 64, (const float*)W_(WS_ROPE)}; GEMM_CALL(EpiInproj, pg8::StaticOrder, g, S, E);
                pg8::Gemm g2{(const bf16*)W_(WS_WIN) + (size_t)2560 * 512, (const bf16*)W_(WS_HX), 512, R, 512, 512, 512}; pg8::StaticOrder S2; S2.init(512, R, G, (bx + G - (2640 % G)) % G);
                EpiVT E2{(unsigned char*)W_(WS_RA + OFF_V)}; GEMM_CALL(EpiVT, pg8::StaticOrder, g2, S2, E2); } }
        SEAM(P + 1);
        if (IN(P + 2)) { ENV
            if (C(4)) REPEAT(4) { pg8::Gemm g{(const bf16*)Y_(0), (const bf16*)W_(WS_WE), 16 * SROWS, 16 * 256, 1024, SLD, 1024}; S5Order S; S.init(1, G, bx); EpiS5E E{(float*)W_(WS_E)}; GEMM_CALL(EpiS5E, S5Order, g, S, E); }
            if (C(5)) REPEAT(5) { int hl_ = lane_id(); asm volatile("" : "+v"(hl_)); const int NU_ = NB * NCH * 4; hg::Raw raw_;
                const hg::Ptrs hp_{H5P, H5P + (size_t)R * 256, H5P + (size_t)2 * R * 256, H5P + (size_t)3 * R * 256, H5P + (size_t)4 * R * 256};
                { const int hh = vcu & 3, cb = vcu >> 2, b = cb / NCH, c = cb - b * NCH; hg::load_unit<0>(raw_, b, c, hh, hp_, (const float*)W_(WS_RB), wv, hl_); }
                for (int u = vcu; u < NU_; u = hg_next_unit(u, vcu, bx, G, 80, 12)) { const int hh = u & 3, cb = u >> 2, b = cb / NCH, c = cb - b * NCH; const int un = hg_next_unit(u, vcu, bx, G, 80, 12); const bool hn = un < NU_; const int nhh = un & 3, ncb = un >> 2, nb = ncb / NCH, nc = ncb - nb * NCH;
                    hg::unit<0>(raw_, b, c, hh, hn, nb, nc, nhh, hp_, (const float*)W_(WS_MISC) + l * 512, in.p[I_HGN] + l * 64, (float*)W_(WS_RB), (float*)W_(WS_DEC), (bf16*)Y_(OFF_YS) + 256, lds, wv, hl_); } } }
        SEAM(P + 2);
        if (IN(P + 3)) { ENV if (C(6)) { if (wv == 0) s5_carry((const float*)W_(WS_E), (bf16*)Y_(0), (const float*)W_(WS_POW), l, vcu * 64 + LANE, G * 64);     hg::carry((float*)W_(WS_RB), (const float*)W_(WS_DEC), G, TID); } }
        SEAM(P + 3);
        if (IN(P + 4)) { ENV
            if (C(7)) REPEAT(7) { pg8::Gemm g{(const bf16*)Y_(0), (const bf16*)W_(WS_WTOT), 16 * SROWS, 16 * 1024, SLD, SLD, SLD}; S5Order S; S.init(4, G, bx);
                EpiS5Out E{(const bf16*)Y_(0), in.p[I_S5D] + l * 256, (bf16*)Y_(OFF_YS)}; GEMM_CALL(EpiS5Out, S5Order, g, S, E); }
            if (C(8)) REPEAT(8) { int hl_ = lane_id(); asm volatile("" : "+v"(hl_)); const int NU_ = NB * NCH * 4; hg::Raw raw_;
                const hg::Ptrs hp_{H5P, H5P + (size_t)R * 256, H5P + (size_t)2 * R * 256, H5P + (size_t)3 * R * 256, H5P + (size_t)4 * R * 256};
                { const int hh = vcu & 3, cb = vcu >> 2, b = cb / NCH, c = cb - b * NCH; hg::load_unit<1>(raw_, b, c, hh, hp_, (const float*)W_(WS_RB), wv, hl_); }
                for (int u = vcu; u < NU_; u = hg_next_unit(u, vcu, bx, G, 64, 13)) { const int hh = u & 3, cb = u >> 2, b = cb / NCH, c = cb - b * NCH; const int un = hg_next_unit(u, vcu, bx, G, 64, 13); const bool hn = un < NU_; const int nhh = un & 3, ncb = un >> 2, nb = ncb / NCH, nc = ncb - nb * NCH;
                    hg::unit<1>(raw_, b, c, hh, hn, nb, nc, nhh, hp_, (const float*)W_(WS_MISC) + l * 512, in.p[I_HGN] + l * 64, (float*)W_(WS_RB), (float*)W_(WS_DEC), (bf16*)Y_(OFF_YS) + 256, lds, wv, hl_); } } }
        SEAM(P + 4);
        if (IN(P + 5)) { ENV
            if (C(9)) { pg8::Gemm g{(const bf16*)Y_(OFF_YS), (const bf16*)W_(WS_WGLU), R, 256, 256, 512, 256}; RowOrder S; S.init(256, G, bx, l == 1);
                EpiGlu E{(bf16*)Y_(OFF_YS), in.p[I_GLUB] + l * 256}; GEMM_CALL(EpiGlu, RowOrder, g, S, E); }
            if (C(10)) REPEAT(10) { const float lam = ((const float*)W_(WS_MISC))[1024 + l], oscale = 1.f - ((const float*)W_(WS_MISC))[1026 + l];
                const int nu = 2048 + (l == 0 ? 64 : 0);
                for (int u = vcu; u < nu; u += G) {
                    int b, h, qrow0, seq;
                    if (u < 2048) { const int bh = u >> 6, qb = u & 63; b = bh >> 2; h = bh & 3; qrow0 = CTX + qb * 128; seq = RB; }
                    else { const int v = u - 2048; b = v >> 3; h = (v >> 1) & 3; qrow0 = (v & 1) * 128; seq = CTX; }
                    const size_t rb = (size_t)b * RB;
                    att::diff_attn_unit((const bf16*)W_(WS_RA + OFF_Q) + (rb + qrow0) * 512 + h * 128, (const unsigned char*)W_(WS_RA + OFF_K) + rb * 512 + h * 128, (const unsigned char*)W_(WS_RA + OFF_V) + ((size_t)b * 512 + h * 128) * RB,
                                        (bf16*)Y_(0) + (rb + qrow0) * 512 + h * 128, seq, lam, oscale, in.p[I_SUBLN] + l * 128, in.p[I_QG] + l * 64, (const float*)W_(WS_ROPE), (u < 2048) ? (qrow0 - CTX) : -1, (LAS char*)lds, wv);
                } } }
        SEAM(P + 5);
        if (IN(P + 6)) { ENV if (C(11)) REPEAT(11) { pg8::Gemm g{(const bf16*)W_(WS_HX), (const bf16*)W_(WS_WIN) + (size_t)3072 * 512, R, 3072, 512, 512, 512}; RowOrder S; S.init(3072, G, bx, l == 1);
            EpiGates E{(unsigned char*)W_(WS_RA)}; GEMM_CALL(EpiGates, RowOrder, g, S, E); } }
        SEAM(P + 6);
        if (IN(P + 7)) { ENV if (C(12)) REPEAT(12) { RowOrder S; S.init(1024, G, bx, l == 1);
            pg8::Gemm g{(const bf16*)Y_(0), (const bf16*)W_(WS_WOA), R, 1024, 1024, 512, 1024, (const bf16*)Y_(OFF_YS), 8, 12};
            EpiMerge E{(const unsigned char*)W_(WS_RA), (bf16*)W_(WS_RB)}; GEMM_CALL(EpiMerge, RowOrder, g, S, E); } }
        SEAM(P + 7);
        if (IN(P + 8)) { ENV if (C(15)) for (int rep_ = 0; rep_ <= (int)(((REP_MASK >> 15) & 1u) && l == 0); ++rep_) { pg8::Gemm g{(const bf16*)W_(WS_RB), (const bf16*)W_(WS_WOUT), R, 1024, 1024, 1024, 1024}; RowOrder S; S.init(1024, G, bx, l == 1);
            EpiWout E{XIN_LAT, XIN_CTX, (bf16*)W_(WS_XS), (float*)W_(WS_CTXS), MODL, l}; GEMM_CALL(EpiWout, RowOrder, g, S, E); } }
        SEAM(P + 8);
#define ASG_GID ((int*)W_(WS_ASG))
#define ASG_POS (ASG_GID + 2 * R)
#define ASG_W ((float*)(ASG_POS + 2 * R))
        if (IN(P + 9)) { ENV if (C(16)) REPEAT(16) { { int nl_ = lane_id(); asm volatile("" : "+v"(nl_)); norm_route((const bf16*)W_(WS_XS), (const float*)W_(WS_CTXS), in.p[I_NFFN] + l * DM, MODL, (bf16*)W_(WS_HX), (const bf16*)W_(WS_WRT), in.p[I_MBE] + l * 32, in.p[I_MBG] + l * 4, ASG_GID, ASG_POS, ASG_W, CTL + CW_GCNT + l * 64, lds, l == 1, vcu, G, wv, wv * 64 + nl_, nl_); } for (int i = GTID; i < NSLOT; i += NTH) ((int*)W_(WS_SLOT))[i] = -1; } }
        SEAM(P + 9);
#define SLOT_ROW ((int*)W_(WS_SLOT))
#define SLOT_W ((float*)(SLOT_ROW + NSLOT))
#define TILE_TAB ((int*)W_(WS_TILE))
        if (IN(P + 12)) { ENV if (C(19)) REPEAT(19) moe_scatter(CTL + CW_GCNT + l * 64, ASG_GID, ASG_POS, ASG_W, SLOT_ROW, SLOT_W, TILE_TAB, (const bf16*)W_(WS_HX), (bf16*)W_(WS_RA), lds, GW, NGW, TID, LANE); }
        SEAM(P + 12);
        if (IN(P + 13)) { ENV if (C(20)) REPEAT(20) { const int nt = TILE_TAB[1025]; pg8::Gemm g{(const bf16*)W_(WS_HX), (const bf16*)W_(WS_WGU), nt * 256, 1024, 1024, 1024, 1024}; MoeOrderT<true> S; S.init(TILE_TAB, SLOT_ROW, 0, nt, G, bx);
            EpiMoe1 E{(bf16*)W_(WS_RB)}; GEMM_CALL(EpiMoe1, MoeOrderT<true>, g, S, E); } }
        SEAM(P + 13);
        if (IN(P + 14)) { ENV if (C(21)) REPEAT(21) { const int nt0 = TILE_TAB[1024]; pg8::Gemm g{(const bf16*)W_(WS_RB), (const bf16*)W_(WS_WDN), nt0 * 256, 1024, 512, 512, 512}; MoeOrderT<false> S; S.init(TILE_TAB, SLOT_ROW, 0, nt0, G, bx);
            EpiMoe2<0> E{SLOT_ROW, SLOT_W, (bf16*)W_(WS_XS), out, (float*)W_(WS_CTXS), MODL, (bf16*)W_(WS_RA), 1.f, l}; GEMM_CALL(EpiMoe2<0>, MoeOrderT<false>, g, S, E); } }
        SEAM(P + 14);
        if (IN(P + 15)) { ENV if (C(22)) { const int nt0 = TILE_TAB[1024], nt = TILE_TAB[1025]; pg8::Gemm g{(const bf16*)W_(WS_RB), (const bf16*)W_(WS_WDN), nt * 256, 1024, 512, 512, 512}; MoeOrderT<false> S; S.init(TILE_TAB, SLOT_ROW, nt0, nt - nt0, G, bx);
            EpiMoe2<1> E{SLOT_ROW, SLOT_W, (bf16*)W_(WS_XS), out, (float*)W_(WS_CTXS), MODL, (bf16*)W_(WS_RA), 1.f, l}; GEMM_CALL(EpiMoe2<1>, MoeOrderT<false>, g, S, E); } }
        SEAM(P + 15);
    }
#undef IN
#undef SEAM
}


#ifdef DBG_DUMP_OFF
__global__ void dbg_dump(const unsigned char* ws, float* out, size_t n) {
    for (size_t i = (size_t)blockIdx.x * 256 + threadIdx.x; i < n; i += (size_t)gridDim.x * 256) {
#if DBG_DUMP_F32
        out[i] = ((const float*)(ws + DBG_DUMP_OFF))[i];
#else
        out[i] = bf2f(((const bf16*)(ws + DBG_DUMP_OFF))[i]);
#endif
    }
}
#endif

#ifndef DBG_LAYER
#define DBG_LAYER 0
#endif
#ifndef DBG_LAST
#define DBG_LAST NPHASE
#endif
#ifndef MK_MULTI
#define MK_MULTI 0
#endif
extern "C" void kernel_launch(void* const* d_in, const int* in_sizes, int n_in, void* d_out, int out_size, void* d_ws, size_t ws_size, hipStream_t stream) {
    static int grid = 0;
    if (grid == 0) {
        if (n_in != 36 || out_size != NB * SEQ * DM || ws_size < WS_END) { fprintf(stderr, "kernel_launch: unexpected shapes (n_in %d out %d ws %zu, need ws >= %zu)\n", n_in, out_size, ws_size, (size_t)WS_END); grid = -1; return; }
        int dev = 0, cus = 0, per_cu = 0;
        if (hipGetDevice(&dev) != hipSuccess || hipDeviceGetAttribute(&cus, hipDeviceAttributeMultiprocessorCount, dev) != hipSuccess) { grid = -1; return; }
        if (hipFuncSetAttribute((const void*)hdt_fwd, hipFuncAttributeMaxDynamicSharedMemorySize, LDS_BYTES) != hipSuccess) { fprintf(stderr, "kernel_launch: hipFuncSetAttribute failed\n"); grid = -1; return; }
        if (hipOccupancyMaxActiveBlocksPerMultiprocessor(&per_cu, (const void*)hdt_fwd, 512, LDS_BYTES) != hipSuccess || per_cu < 1) fprintf(stderr, "kernel_launch: occupancy query reports %d\n", per_cu);
        (void)hipGetLastError();
        grid = cus;
    }
    if (grid < 0) return;
    if (hipMemsetAsync((char*)d_ws + WS_CTL, 0, CTL_BYTES, stream) != hipSuccess) return;
    Args a{};
    for (int i = 0; i < 36; ++i) a.in.p[i] = (const float*)d_in[i];
    a.out = (float*)d_out; a.ws = (unsigned char*)d_ws;
#if MK_MULTI
    for (int p = 0; p < DBG_LAST; ++p) { a.ph_lo = p; a.ph_hi = p + 1; hipLaunchKernelGGL(hdt_fwd, dim3(grid), dim3(512), LDS_BYTES, stream, a);
    }
#else
    a.ph_lo = 0; a.ph_hi = NPHASE; hipLaunchKernelGGL(hdt_fwd, dim3(grid), dim3(512), LDS_BYTES, stream, a);
#endif
#ifdef DBG_COPY_X
    (void)hipMemcpyAsync(d_out, d_in[0], (size_t)NB * SEQ * DM * 4, hipMemcpyDeviceToDevice, stream);
#endif
#ifdef DBG_DUMP_OFF
    hipLaunchKernelGGL(dbg_dump, dim3(2048), dim3(256), 0, stream, (const unsigned char*)d_ws, (float*)d_out, (size_t)NB * SEQ * DM);
#endif
    const hipError_t le = hipPeekAtLastError();
    if (le != hipSuccess) fprintf(stderr, "kernel_launch: launch failed: %s\n", hipGetErrorName(le));
}
```

```cpp
#include <hip/hip_runtime.h>
#include <cstdio>
#include <cstdint>

#define LAS __attribute__((address_space(3)))
#define GAS __attribute__((address_space(1)))
typedef unsigned short bf16;
typedef short bf16x8 __attribute__((ext_vector_type(8)));
typedef short s16x4 __attribute__((ext_vector_type(4)));
typedef float f32x2 __attribute__((ext_vector_type(2)));
typedef float f32x4 __attribute__((ext_vector_type(4)));
typedef float f32x16 __attribute__((ext_vector_type(16)));
typedef unsigned u32x4 __attribute__((ext_vector_type(4)));
typedef unsigned u32x2 __attribute__((ext_vector_type(2)));

constexpr int NB = 8, SEQ = 8192, CTX = 256, RB = SEQ + CTX, R = NB * RB, DM = 1024;
constexpr int NTILE = R / 256;
constexpr int TPB = RB / 256;
constexpr int NCH = RB / 64;
constexpr int NCHT = NB * NCH;
constexpr int SROWS = 1280;
constexpr int SLD = 1280;
constexpr int NEXP = 32;
constexpr int MAXTILES = 2 * NTILE + 64;
constexpr int NSLOT = MAXTILES * 256;
constexpr float RMS_EPS = 1e-6f;
constexpr float LOG2E = 1.4426950408889634f;

__device__ __forceinline__ int lane_id() { int r; asm volatile("v_mbcnt_lo_u32_b32 %0, -1, 0\n\tv_mbcnt_hi_u32_b32 %0, -1, %0" : "=v"(r)); return r; }
__device__ __forceinline__ float bf2f(bf16 h) { return __builtin_bit_cast(float, (unsigned)h << 16); }
typedef float f32x2_t __attribute__((ext_vector_type(2))); typedef __bf16 bf16x2_t __attribute__((ext_vector_type(2)));
__device__ __forceinline__ unsigned cvt_pk_bf16(float lo, float hi) { f32x2_t v = {lo, hi}; bf16x2_t b = __builtin_convertvector(v, bf16x2_t); return __builtin_bit_cast(unsigned, b); }
__device__ __forceinline__ bf16 f2bf(float f) { return (bf16)(cvt_pk_bf16(f, 0.f) & 0xffffu); }
__device__ __forceinline__ float fexp(float x) { return __builtin_amdgcn_exp2f(x * LOG2E); }
__device__ __forceinline__ float fsigmoid(float x) { return __builtin_amdgcn_rcpf(1.f + fexp(-x)); }
__device__ __forceinline__ float fsilu(float x) { return x * fsigmoid(x); }
__device__ __forceinline__ float fgelu_tanh(float x) { const float u = 0.7978845608028654f * (x + 0.044715f * x * x * x); const float t = 1.f - 2.f * __builtin_amdgcn_rcpf(fexp(2.f * u) + 1.f); return 0.5f * x * (1.f + t); }
__device__ __forceinline__ void unpack8(u32x4 w, float (&f)[8]) {
    f[0] = __builtin_bit_cast(float, w.x << 16); f[1] = __builtin_bit_cast(float, w.x & 0xffff0000u);
    f[2] = __builtin_bit_cast(float, w.y << 16); f[3] = __builtin_bit_cast(float, w.y & 0xffff0000u);
    f[4] = __builtin_bit_cast(float, w.z << 16); f[5] = __builtin_bit_cast(float, w.z & 0xffff0000u);
    f[6] = __builtin_bit_cast(float, w.w << 16); f[7] = __builtin_bit_cast(float, w.w & 0xffff0000u);
}
__device__ __forceinline__ u32x4 pack8(const float (&f)[8]) { u32x4 w; w.x = cvt_pk_bf16(f[0], f[1]); w.y = cvt_pk_bf16(f[2], f[3]); w.z = cvt_pk_bf16(f[4], f[5]); w.w = cvt_pk_bf16(f[6], f[7]); return w; }
__device__ __forceinline__ float shx(float v, int m, int lane) { return __builtin_bit_cast(float, __builtin_amdgcn_ds_bpermute((lane ^ m) << 2, __builtin_bit_cast(int, v))); }
__device__ __forceinline__ float wave_sum(float v, int lane) {
#pragma unroll
    for (int o = 1; o < 64; o <<= 1) v += shx(v, o, lane);
    return v;
}

namespace pg8 {
#define PG8_LAS __attribute__((address_space(3)))
typedef unsigned short bf16_t;
constexpr int BM = 256, BK = 64, HALF = 128, HTB = HALF * BK * 2  , STAGE_BYTES = 8 * HTB, NXCD = 8, WGM = 8;
__host__ __device__ __forceinline__ int lds_byte(int r, int c) { const int st = (r >> 4) * 2 + (c >> 5), rr = r & 15, cc = c & 31, ob = rr * 64 + cc * 2; return st * 1024 + (ob ^ (((ob >> 9) & 1) << 5)); }
__host__ __device__ __forceinline__ void stage_rc(int b, int& R, int& C) { const int st = b / 1024, sb = b % 1024, swz = sb ^ (((sb >> 9) & 1) << 5); R = (st >> 1) * 16 + swz / 64; C = (st & 1) * 32 + (swz % 64) / 2; }
__host__ __device__ __forceinline__ int perm32(int rho) { const int n = rho >> 4, i = rho & 15; return 8 * (i >> 2) + 4 * n + (i & 3); }
struct Unit { int pm, pn; };
struct Gemm { const bf16_t* A; const bf16_t* Bt; int M, N, K, lda, ldb; const bf16_t* A2; int ksplit, ksplit2; };
struct StaticOrder { static constexpr bool GATHER = false;
    int nM, nN, nwg, G, c;
    __host__ __device__ void init(int M, int N, int G_, int c_) { nM = M / BM; nN = N / BM; nwg = nM * nN; G = G_; c = c_; }
    __host__ __device__ bool next(int i, Unit& u) const {
        const long L = (long)i * G + c; if (L >= nwg) return false;
        int wgid = (int)L; { const int q = nwg / NXCD, r = nwg % NXCD, xcd = wgid % NXCD, off = wgid / NXCD; wgid = (xcd < r ? xcd * (q + 1) : r * (q + 1) + (xcd - r) * q) + off; }
        const int nig = WGM * nN, gid = wgid / nig, fm = gid * WGM, gsz = (nM - fm) < WGM ? (nM - fm) : WGM;
        u.pm = fm + ((wgid % nig) % gsz); u.pn = (wgid % nig) / gsz; return true;
    }
    __device__ __forceinline__ void a_ready(const Unit&) const {}
    __device__ __forceinline__ void done(const Unit&) const {}
};
template <class E> struct epi_fp8 { static constexpr bool v = false; };
typedef int v8i_t __attribute__((ext_vector_type(8)));
typedef int v4i_t __attribute__((ext_vector_type(4)));
template <class Epi, class Sched, bool ALIGN_EPI = false, bool SP2 = false>
__device__ __forceinline__ void gemm_phase(PG8_LAS unsigned char* lds, const Gemm g, const Sched& S, const Epi& E, const int wv) {
    int lane_ = lane_id(); asm volatile("" : "+v"(lane_)); const int tid = wv * 64 + lane_, wid = wv, lane = tid & 63, wr = wid >> 2, wc = wid & 3, fr = lane & 15, fq = lane >> 4;
    const int K = g.K, nt = K / BK;
    unsigned voffA0, voffB0;
    { int R, C; stage_rc(tid * 16, R, C); const int Rb = Epi::PERM ? ((R & ~31) + perm32(R & 31)) : R; voffA0 = (unsigned)(R * g.lda + C) * 2u; voffB0 = (unsigned)(Rb * g.ldb + C) * 2u; }
    const size_t pstepA = (size_t)64 * g.lda * 2, pstepB = (size_t)64 * g.ldb * 2;
    const size_t kstep = (size_t)(BK * 2);
    constexpr bool GA = Sched::GATHER; static_assert(!GA || SP2, "gathered A rows: SP2 loop only");
    const size_t hstepA = GA ? 0 : (size_t)HALF * g.lda * 2, hstepB = (size_t)HALF * g.ldb * 2;
    const size_t tstepA = 2 * hstepA, tstepB = 2 * hstepB;
    const unsigned ldsw = (unsigned)wid * 1024u;
    const int aoff = lds_byte(wr * 64 + fr, fq * 8), boff = lds_byte(wc * 32 + fr, fq * 8);
#define PG8_SA(b, h) (((b) * 2 + (h)) * HTB)
#define PG8_SB(b, h) ((4 + (b) * 2 + (h)) * HTB)
#define PG8_STAGE(bufoff, gbase, voff) do { _Pragma("unroll") for (int _i = 0; _i < 2; ++_i) \
        __builtin_amdgcn_global_load_lds((const unsigned*)((const char*)(gbase) + (voff)[_i]), (PG8_LAS unsigned*)(lds + (bufoff) + ldsw + _i * 8192), 16, 0, 0); } while (0)
#define PG8_STAGEU(bufoff, gbase, v0, pstep) do { _Pragma("unroll") for (int _i = 0; _i < 2; ++_i) \
        __builtin_amdgcn_global_load_lds((const unsigned*)((const char*)(gbase) + _i * (pstep) + (v0)), (PG8_LAS unsigned*)(lds + (bufoff) + ldsw + _i * 8192), 16, 0, 0); } while (0)
#define PG8_LD8(adr) __builtin_shufflevector(*(const PG8_LAS v4i_t*)(adr), *(const PG8_LAS v4i_t*)((adr) + 1024), 0, 1, 2, 3, 4, 5, 6, 7)
#define PG8_LDA(dst, b, h) do { if constexpr (epi_fp8<Epi>::v) { _Pragma("unroll") for (int m = 0; m < 4; ++m) dst##8[m] = PG8_LD8(lds + PG8_SA(b, h) + aoff + m * 2048); } \
        else { _Pragma("unroll") for (int m = 0; m < 4; ++m) _Pragma("unroll") for (int k = 0; k < 2; ++k) dst[m][k] = *(const PG8_LAS bf16x8*)(lds + PG8_SA(b, h) + aoff + m * 2048 + k * 1024); } } while (0)
#define PG8_LDB(dst, b, h) do { if constexpr (epi_fp8<Epi>::v) { _Pragma("unroll") for (int n = 0; n < 2; ++n) dst##8[n] = PG8_LD8(lds + PG8_SB(b, h) + boff + n * 2048); } \
        else { _Pragma("unroll") for (int n = 0; n < 2; ++n) _Pragma("unroll") for (int k = 0; k < 2; ++k) dst[n][k] = *(const PG8_LAS bf16x8*)(lds + PG8_SB(b, h) + boff + n * 2048 + k * 1024); } } while (0)
#define PG8_MMA(ai, bj, At, Bt) do { __builtin_amdgcn_s_setprio(1); \
        if constexpr (epi_fp8<Epi>::v) { _Pragma("unroll") for (int m = 0; m < 4; ++m) _Pragma("unroll") for (int n = 0; n < 2; ++n) \
            acc[ai][bj][m][n] = __builtin_amdgcn_mfma_scale_f32_16x16x128_f8f6f4(Bt##8[n], At##8[m], acc[ai][bj][m][n], 0, 0, 0, 0x7c7c7c7c, 0, 0x7c7c7c7c); } \
        else { _Pragma("unroll") for (int m = 0; m < 4; ++m) _Pragma("unroll") for (int n = 0; n < 2; ++n) _Pragma("unroll") for (int k = 0; k < 2; ++k) \
            acc[ai][bj][m][n] = __builtin_amdgcn_mfma_f32_16x16x32_bf16(Bt[n][k], At[m][k], acc[ai][bj][m][n], 0, 0, 0); } \
        __builtin_amdgcn_s_setprio(0); } while (0)
#define PG8_WAIT_V(n) asm volatile("s_waitcnt vmcnt(" #n ")" ::: "memory")
#define PG8_WAIT_L(n) asm volatile("s_waitcnt lgkmcnt(" #n ")" ::: "memory")
#define PG8_BAR __builtin_amdgcn_s_barrier()
#define PG8_SCHED __builtin_amdgcn_sched_barrier(0)
    Unit cur, nxt; int ui = 0;
    if (!S.next(0, cur)) return;
    unsigned vA[2][2] = {{0u, 0u}, {0u, 0u}}, vN[2][2] = {{0u, 0u}, {0u, 0u}};
#define PG8_GOFF(dst, un) do { if constexpr (GA) { _Pragma("unroll") for (int h_ = 0; h_ < 2; ++h_) _Pragma("unroll") for (int i_ = 0; i_ < 2; ++i_) { int R_, C_; stage_rc(tid * 16 + i_ * 8192, R_, C_); \
        dst[h_][i_] = (unsigned)(S.arow(un, h_ * 128 + R_) * g.lda + C_) * 2u; } } } while (0)
#define PG8_ASTG(b, h, base, nextsel) do { if constexpr (GA) { if (nextsel) { PG8_STAGE(PG8_SA(b, h), base, vN[h]); } else { PG8_STAGE(PG8_SA(b, h), base, vA[h]); } } else { PG8_STAGEU(PG8_SA(b, h), base, voffA0, pstepA); } } while (0)
    PG8_GOFF(vA, cur);
    f32x4 acc[2][2][4][2];
#pragma unroll
    for (int a = 0; a < 2; ++a)
#pragma unroll
        for (int b = 0; b < 2; ++b)
#pragma unroll
            for (int m = 0; m < 4; ++m)
#pragma unroll
                for (int n = 0; n < 2; ++n) acc[a][b][m][n] = (f32x4){0.f, 0.f, 0.f, 0.f};
    bf16x8 At[4][2], B0[2][2], B1[2][2]; v8i_t At8[4], B08[2], B18[2]; (void)At; (void)B0; (void)B1; (void)At8; (void)B08; (void)B18;
    const char* cA = (const char*)g.A + (size_t)cur.pm * tstepA; const char* cB = (const char*)g.Bt + (size_t)cur.pn * tstepB;
    const char* cA2 = nullptr; if constexpr (Epi::SEG2) cA2 = (const char*)g.A2 + (size_t)cur.pm * tstepA - (size_t)g.ksplit * (BK * 2);
    S.a_ready(cur);
    if constexpr (SP2) {
        PG8_STAGEU(PG8_SB(0, 0), cB, voffB0, pstepB); PG8_STAGEU(PG8_SB(0, 1), cB + hstepB, voffB0, pstepB); PG8_ASTG(0, 0, cA, false); PG8_ASTG(0, 1, cA + hstepA, false);
        if (wr == 1) PG8_BAR;
        PG8_WAIT_V(2); PG8_BAR;
        PG8_STAGEU(PG8_SB(1, 0), cB + kstep, voffB0, pstepB); PG8_ASTG(1, 0, cA + kstep, false); PG8_STAGEU(PG8_SB(1, 1), cB + hstepB + kstep, voffB0, pstepB);
        PG8_WAIT_V(6); PG8_BAR;
    } else {
        PG8_STAGEU(PG8_SB(0, 0), cB, voffB0, pstepB); PG8_STAGEU(PG8_SA(0, 0), cA, voffA0, pstepA); PG8_STAGEU(PG8_SB(0, 1), cB + hstepB, voffB0, pstepB); PG8_STAGEU(PG8_SA(0, 1), cA + hstepA, voffA0, pstepA);
        if (wr == 1) PG8_BAR;
        PG8_WAIT_V(4); PG8_BAR;
        PG8_STAGEU(PG8_SB(1, 0), cB + kstep, voffB0, pstepB); PG8_STAGEU(PG8_SA(1, 0), cA + kstep, voffA0, pstepA); PG8_STAGEU(PG8_SB(1, 1), cB + hstepB + kstep, voffB0, pstepB);
        PG8_WAIT_V(6); PG8_BAR;
    }
    for (;;) {
        const bool has_next = S.next(ui + 1, nxt);
        if constexpr (GA) { if (has_next) PG8_GOFF(vN, nxt); else { vN[0][0] = vA[0][0]; vN[0][1] = vA[0][1]; vN[1][0] = vA[1][0]; vN[1][1] = vA[1][1]; } }
        const char* nA2 = nullptr; if constexpr (Epi::SEG2) nA2 = has_next ? (const char*)g.A2 + (size_t)nxt.pm * tstepA - (size_t)g.ksplit * (BK * 2) : cA2;
        const char* nA = has_next ? (const char*)g.A + (size_t)nxt.pm * tstepA : cA; const char* nB = has_next ? (const char*)g.Bt + (size_t)nxt.pn * tstepB : cB;
#pragma clang loop unroll(disable)
        for (int t = 0; t < nt; t += 2) {
            const bool last = (t == nt - 2);
            asm volatile("" : "+v"(voffA0), "+v"(voffB0));
            if constexpr (Epi::MID) { if (t == g.ksplit || t == g.ksplit2) { const int l3 = lane_id(); E.mid(acc, cur, t, wr, wc, l3 & 15, l3 >> 4); } }
            const char* a1 = ((Epi::SEG2 && t + 1 >= g.ksplit) ? cA2 : cA) + (size_t)(t + 1) * kstep;
            const char* a2 = last ? nA : ((Epi::SEG2 && t + 2 >= g.ksplit) ? cA2 : cA) + (size_t)(t + 2) * kstep; const char* b2 = last ? nB : cB + (size_t)(t + 2) * kstep;
            const char* a3 = a2 + kstep; const char* b3 = b2 + kstep;
            if (last && has_next) S.a_ready(nxt);
            if constexpr (SP2) {
            PG8_LDB(B0, 0, 0); PG8_LDB(B1, 0, 1); PG8_SCHED; PG8_LDA(At, 0, 0); PG8_ASTG(1, 1, a1 + hstepA, false);
            PG8_WAIT_V(8); PG8_WAIT_L(0); PG8_BAR; PG8_MMA(0, 0, At, B0); PG8_MMA(0, 1, At, B1); PG8_BAR; PG8_SCHED;
            PG8_LDA(At, 0, 1); PG8_STAGEU(PG8_SB(0, 0), b2, voffB0, pstepB); PG8_STAGEU(PG8_SB(0, 1), b2 + hstepB, voffB0, pstepB); PG8_ASTG(0, 0, a2, last);
            PG8_WAIT_V(8); PG8_WAIT_L(0); PG8_BAR; PG8_MMA(1, 0, At, B0); PG8_MMA(1, 1, At, B1); PG8_BAR; PG8_SCHED;
            PG8_LDB(B0, 1, 0); PG8_LDB(B1, 1, 1); PG8_SCHED; PG8_LDA(At, 1, 0); PG8_ASTG(0, 1, a2 + hstepA, last);
            PG8_WAIT_V(8); PG8_WAIT_L(0); PG8_BAR; PG8_MMA(0, 0, At, B0); PG8_MMA(0, 1, At, B1); PG8_BAR; PG8_SCHED;
            PG8_LDA(At, 1, 1); PG8_STAGEU(PG8_SB(1, 0), b3, voffB0, pstepB); PG8_STAGEU(PG8_SB(1, 1), b3 + hstepB, voffB0, pstepB); PG8_ASTG(1, 0, a3, last);
            PG8_WAIT_V(8); PG8_WAIT_L(0); PG8_BAR; PG8_MMA(1, 0, At, B0); PG8_MMA(1, 1, At, B1); PG8_BAR; PG8_SCHED;
            } else {
            PG8_LDB(B0, 0, 0); PG8_SCHED; PG8_LDA(At, 0, 0); PG8_STAGEU(PG8_SA(1, 1), a1 + hstepA, voffA0, pstepA);
            PG8_WAIT_L(8); PG8_BAR; PG8_WAIT_L(0); PG8_MMA(0, 0, At, B0); PG8_BAR; PG8_SCHED;
            PG8_LDB(B1, 0, 1); PG8_STAGEU(PG8_SB(0, 0), b2, voffB0, pstepB);
            PG8_BAR; PG8_WAIT_L(0); PG8_MMA(0, 1, At, B1); PG8_BAR;
            PG8_LDA(At, 0, 1); PG8_STAGEU(PG8_SA(0, 0), a2, voffA0, pstepA);
            PG8_BAR; PG8_WAIT_L(0); PG8_MMA(1, 0, At, B0); PG8_BAR; PG8_SCHED;
            PG8_STAGEU(PG8_SB(0, 1), b2 + hstepB, voffB0, pstepB);
            PG8_WAIT_V(6); PG8_BAR; PG8_MMA(1, 1, At, B1); PG8_BAR;
            PG8_LDB(B0, 1, 0); PG8_SCHED; PG8_LDA(At, 1, 0); PG8_STAGEU(PG8_SA(0, 1), a2 + hstepA, voffA0, pstepA);
            PG8_WAIT_L(8); PG8_BAR; PG8_WAIT_L(0); PG8_MMA(0, 0, At, B0); PG8_BAR; PG8_SCHED;
            PG8_LDB(B1, 1, 1); PG8_STAGEU(PG8_SB(1, 0), b3, voffB0, pstepB);
            PG8_BAR; PG8_WAIT_L(0); PG8_MMA(0, 1, At, B1); PG8_BAR;
            PG8_LDA(At, 1, 1); PG8_STAGEU(PG8_SA(1, 0), a3, voffA0, pstepA);
            PG8_BAR; PG8_WAIT_L(0); PG8_MMA(1, 0, At, B0); PG8_BAR; PG8_SCHED;
            PG8_STAGEU(PG8_SB(1, 1), b3 + hstepB, voffB0, pstepB);
            PG8_WAIT_V(6); PG8_BAR; PG8_MMA(1, 1, At, B1); PG8_BAR;
            }
        }
        if constexpr (ALIGN_EPI) { if (wr == 0) PG8_BAR; }
        if constexpr (!Epi::AFTER_DRAIN) { const int l2 = lane_id(); E(acc, cur, wr, wc, l2 & 15, l2 >> 4); S.done(cur); }
        if (!has_next) break;
#pragma unroll
        for (int a = 0; a < 2; ++a)
#pragma unroll
            for (int b = 0; b < 2; ++b)
#pragma unroll
                for (int m = 0; m < 4; ++m)
#pragma unroll
                    for (int n = 0; n < 2; ++n) acc[a][b][m][n] = (f32x4){0.f, 0.f, 0.f, 0.f};
        cur = nxt; cA = nA; cB = nB; ++ui; if constexpr (Epi::SEG2) cA2 = nA2;
        if constexpr (GA) { vA[0][0] = vN[0][0]; vA[0][1] = vN[0][1]; vA[1][0] = vN[1][0]; vA[1][1] = vN[1][1]; }
        if constexpr (ALIGN_EPI) { if (wr == 1) PG8_BAR; }
    }
    PG8_WAIT_V(0);
    if constexpr (!ALIGN_EPI) { if (wr == 0) PG8_BAR; }
    PG8_BAR;
    if constexpr (Epi::AFTER_DRAIN) { E.fused(acc, cur, wr, wc, fr, fq, lds, wid, lane); S.done(cur); }
#undef PG8_SA
#undef PG8_GOFF
#undef PG8_ASTG
#undef PG8_SB
#undef PG8_STAGE
#undef PG8_LDA
#undef PG8_LDB
#undef PG8_MMA
#undef PG8_WAIT_V
#undef PG8_WAIT_L
#undef PG8_BAR
#undef PG8_SCHED
}
}

using pg8::Unit;
struct S5Order { static constexpr bool GATHER = false;
    int nct, total, G, c;
    __device__ void init(int nct_, int G_, int c_) { nct = nct_; total = 16 * 5 * nct_; G = G_; c = c_; }
    __device__ bool next(int i, Unit& u) const { const int L = i * G + c; if (L >= total) return false; const int per = 5 * nct, g = L / per, rem = L - g * per; const int ct = rem / 5, rt = rem - ct * 5;
        u.pm = g * 5 + rt; u.pn = g * nct + ct; return true; }
    __device__ __forceinline__ void a_ready(const Unit&) const {}
    __device__ __forceinline__ void done(const Unit&) const {}
};
template <bool GA> struct MoeOrderT {
    static constexpr bool GATHER = GA;
    const int* tile_e; const int* slot_row; int t0, total, G, c;
    __device__ void init(const int* te, const int* sr, int t0_, int nt_, int G_, int c_) { tile_e = te; slot_row = sr; t0 = t0_; total = nt_ * 4; G = G_; c = c_; }
    __device__ bool next(int i, Unit& u) const { const int L = i * G + c; if (L >= total) return false; const int tile = t0 + (L >> 2); u.pm = tile; u.pn = tile_e[tile] * 4 + (L & 3); return true; }
    __device__ __forceinline__ int arow(const Unit& u, int r) const { const int t = slot_row[u.pm * 256 + r]; return t < 0 ? 0 : t; }
    __device__ __forceinline__ void a_ready(const Unit&) const {}
    __device__ __forceinline__ void done(const Unit&) const {}
};

struct InprojOrder { static constexpr bool GATHER = false;
    pg8::StaticOrder so;
    __device__ void init(int M, int G_, int c_) { so.init(M, 11 * 256, G_, c_); }
    __device__ bool next(int i, Unit& u) const { if (!so.next(i, u)) return false; if (u.pn >= 6) u.pn += 1; return true; }
    __device__ __forceinline__ void a_ready(const Unit&) const {}
    __device__ __forceinline__ void done(const Unit&) const {}
};

struct RowOrder { static constexpr bool GATHER = false;
    pg8::StaticOrder so; bool skip;
    __device__ void init(int N, int G_, int c_, bool skip_ctx) { skip = skip_ctx; so.init(skip_ctx ? NB * SEQ : R, N, G_, c_); }
    __device__ bool next(int i, Unit& u) const { if (!so.next(i, u)) return false; if (skip) u.pm += (u.pm >> 5) + 1; return true; }
    __device__ __forceinline__ void a_ready(const Unit&) const {}
    __device__ __forceinline__ void done(const Unit&) const {}
};

#define EPI_ROWS_BEGIN _Pragma("unroll") for (int ai = 0; ai < 2; ++ai) _Pragma("unroll") for (int m = 0; m < 4; ++m) { const int trow = ai * 128 + wr * 64 + m * 16 + fr;
#define EPI_COLS_BEGIN _Pragma("unroll") for (int bj = 0; bj < 2; ++bj) { const int cc = bj * 128 + wc * 32 + 8 * fq; f32x4 v0 = acc[ai][bj][m][0], v1 = acc[ai][bj][m][1]; asm volatile("" : "+v"(v0), "+v"(v1) :: "memory");
#define EPI_END } }
typedef const f32x4 (&AccRef)[2][2][4][2];
#define EPIB_BEGIN _Pragma("unroll") for (int ai = 0; ai < 2; ++ai) _Pragma("unroll") for (int mh = 0; mh < 2; ++mh) {
#define EPIB_ITEMS _Pragma("unroll") for (int mm = 0; mm < 2; ++mm) _Pragma("unroll") for (int bj = 0; bj < 2; ++bj) { const int m = mh * 2 + mm, it4 = mm * 2 + bj, trow = ai * 128 + wr * 64 + m * 16 + fr, cc = bj * 128 + wc * 32 + 8 * fq; (void)it4; (void)trow; (void)cc;
#define EPIB_FENCE } asm volatile("" ::: "memory");
#define EPIB_END }

struct EpiInproj { static constexpr bool PERM = true, AFTER_DRAIN = false, SEG2 = false, MID = false;
    bf16 *Q, *K, *H5, *AG; const float *kg, *rope;
    __device__ __forceinline__ void operator()(AccRef acc, const Unit& u, int wr, int wc, int fr, int fq) const {
        const int pn = u.pn; const bool isag = (pn == 4);
        if (pn == 2 || pn == 3) {
            const int lane = fq * 16 + fr, s64 = ((pn - 2) * 4 + wc) * 64;
            const f32x4 g0a = *(const f32x4*)(kg + 8 * fq), g0b = *(const f32x4*)(kg + 8 * fq + 4), g1a = *(const f32x4*)(kg + 32 + 8 * fq), g1b = *(const f32x4*)(kg + 36 + 8 * fq);
            const int bb = u.pm / TPB; const bool lat = (u.pm - bb * TPB) != 0;
#pragma unroll
            for (int ai = 0; ai < 2; ++ai) {
                f32x4 cz[4][2], sz[4][2];
#pragma unroll
                for (int m = 0; m < 4; ++m) { const int t = lat ? (u.pm - bb * TPB) * 256 + ai * 128 + wr * 64 + m * 16 + fr - CTX : 0; const float* cs = rope + (size_t)t * 32 + 8 * fq; const float* sn = cs + (size_t)SEQ * 32;
                    cz[m][0] = *(const f32x4*)cs; cz[m][1] = *(const f32x4*)(cs + 4); sz[m][0] = *(const f32x4*)sn; sz[m][1] = *(const f32x4*)(sn + 4); }
                asm volatile("" ::: "memory");
#pragma unroll
                for (int m = 0; m < 4; ++m) { const int trow = ai * 128 + wr * 64 + m * 16 + fr; const size_t row = (size_t)u.pm * 256 + trow;
                    f32x4 a0 = acc[ai][0][m][0], a1 = acc[ai][0][m][1], b0 = acc[ai][1][m][0], b1 = acc[ai][1][m][1];
                    const f32x4 one = {1.f, 1.f, 1.f, 1.f}, zero = {0.f, 0.f, 0.f, 0.f};
                    const f32x4 c0 = lat ? cz[m][0] : one, c1 = lat ? cz[m][1] : one, s0 = lat ? sz[m][0] : zero, s1 = lat ? sz[m][1] : zero;
                    float ss = 0.f;
#pragma unroll
                    for (int e = 0; e < 4; ++e) ss += a0[e] * a0[e] + a1[e] * a1[e] + b0[e] * b0[e] + b1[e] * b1[e];
                    ss += shx(ss, 16, lane); ss += shx(ss, 32, lane);
                    const float rinv = __builtin_amdgcn_rsqf(ss * (1.f / 64.f) + RMS_EPS);
                    a0 = a0 * rinv * g0a; a1 = a1 * rinv * g0b; b0 = b0 * rinv * g1a; b1 = b1 * rinv * g1b;
                    const f32x4 lo0 = a0 * c0 - b0 * s0, lo1 = a1 * c1 - b1 * s1, hi0 = b0 * c0 + a0 * s0, hi1 = b1 * c1 + a1 * s1;
                    unsigned char* kp = (unsigned char*)K + row * 512 + s64 + 32 * (fq & 1) + 8 * (fq >> 1);
                    u32x2 w; int t0 = 0, t1 = 0; t0 = __builtin_amdgcn_cvt_pk_fp8_f32(lo0[0], lo0[1], t0, false); t0 = __builtin_amdgcn_cvt_pk_fp8_f32(lo0[2], lo0[3], t0, true);
                    t1 = __builtin_amdgcn_cvt_pk_fp8_f32(lo1[0], lo1[1], t1, false); t1 = __builtin_amdgcn_cvt_pk_fp8_f32(lo1[2], lo1[3], t1, true); w.x = (unsigned)t0; w.y = (unsigned)t1; *(u32x2*)kp = w;
                    t0 = 0; t1 = 0; t0 = __builtin_amdgcn_cvt_pk_fp8_f32(hi0[0], hi0[1], t0, false); t0 = __builtin_amdgcn_cvt_pk_fp8_f32(hi0[2], hi0[3], t0, true);
                    t1 = __builtin_amdgcn_cvt_pk_fp8_f32(hi1[0], hi1[1], t1, false); t1 = __builtin_amdgcn_cvt_pk_fp8_f32(hi1[2], hi1[3], t1, true); w.x = (unsigned)t0; w.y = (unsigned)t1; *(u32x2*)(kp + 16) = w; }
            }
            return;
        }
        bf16* base; int ld;
        if (pn < 4) { base = Q + (size_t)(pn >> 1) * ((size_t)R * 512) + (pn & 1) * 256; ld = 512; } else if (isag) { base = AG; ld = 0; } else { base = H5 + (size_t)(pn - 5) * ((size_t)R * 256); ld = 256; }
        EPI_ROWS_BEGIN const int row = u.pm * 256 + trow;
            const size_t rterm = isag ? (size_t)(row >> 6) * SLD + (row & 63) * 16 : (size_t)row * ld;
        EPI_COLS_BEGIN
            u32x4 w; w.x = cvt_pk_bf16(v0[0], v0[1]); w.y = cvt_pk_bf16(v0[2], v0[3]); w.z = cvt_pk_bf16(v1[0], v1[1]); w.w = cvt_pk_bf16(v1[2], v1[3]);
            const size_t cterm = isag ? (size_t)(cc >> 4) * ((size_t)SROWS * SLD) + (cc & 15) : (size_t)cc;
            *(u32x4*)(base + rterm + cterm) = w;
        EPI_END
    }
};
struct EpiVT { static constexpr bool PERM = true, AFTER_DRAIN = false, SEG2 = false, MID = false;
    unsigned char* VT;
    __device__ __forceinline__ void operator()(AccRef acc, const Unit& u, int wr, int wc, int fr, int fq) const {
        const int b = u.pn / TPB, tok0 = (u.pn - b * TPB) * 256;
        EPI_ROWS_BEGIN const int dvg = u.pm * 256 + trow; unsigned char* rowp = VT + ((size_t)b * 512 + dvg) * RB + tok0;
        EPI_COLS_BEGIN
            const int blk = cc & ~63, j0 = (cc & 63) >> 1;
            int w0 = 0, w1 = 0; w0 = __builtin_amdgcn_cvt_pk_fp8_f32(v0[0], v0[1], w0, false); w0 = __builtin_amdgcn_cvt_pk_fp8_f32(v0[2], v0[3], w0, true);
            w1 = __builtin_amdgcn_cvt_pk_fp8_f32(v1[0], v1[1], w1, false); w1 = __builtin_amdgcn_cvt_pk_fp8_f32(v1[2], v1[3], w1, true);
            *(int*)(rowp + blk + j0) = w0; *(int*)(rowp + blk + 32 + j0) = w1;
        EPI_END
    }
};
namespace pg8 { template <> struct epi_fp8<EpiInproj> { static constexpr bool v = true; }; template <> struct epi_fp8<EpiVT> { static constexpr bool v = true; }; }
struct EpiS5U { static constexpr bool PERM = true, AFTER_DRAIN = false, SEG2 = false, MID = false;
    bf16* AG;
    __device__ __forceinline__ void operator()(AccRef acc, const Unit& u, int wr, int wc, int fr, int fq) const {
        EPI_ROWS_BEGIN const int row = u.pm * 256 + trow;
        EPI_COLS_BEGIN
            u32x4 w; w.x = cvt_pk_bf16(v0[0], v0[1]); w.y = cvt_pk_bf16(v0[2], v0[3]); w.z = cvt_pk_bf16(v1[0], v1[1]); w.w = cvt_pk_bf16(v1[2], v1[3]);
            *(u32x4*)(AG + ((size_t)((cc >> 4) * SROWS + (row >> 6))) * SLD + (row & 63) * 16 + (cc & 15)) = w;
        EPI_END
    }
};
__device__ __forceinline__ size_t gtile_off(int pm, int pnG, int wr, int wc, int fr, int fq, int ai, int m, int bj) { return ((size_t)(pm * 12 + pnG) << 16) + (size_t)((((wr * 4 + wc) * 16 + (ai * 8 + m * 2 + bj)) * 64 + (fq * 16 + fr)) * 8); }
__device__ __forceinline__ unsigned gq8(float z) { return (unsigned)__builtin_amdgcn_rcpf(fmaf(__builtin_amdgcn_exp2f(z), 0.00390625f, 0.00390625f * (1.f + 1.f / 4096.f))); }
__device__ __forceinline__ void gdq8(u32x2 w, float (&g)[8]) {
    g[0] = ((float)(w.x & 255u) + 0.5f) * (1.f / 256.f); g[1] = ((float)((w.x >> 8) & 255u) + 0.5f) * (1.f / 256.f); g[2] = ((float)((w.x >> 16) & 255u) + 0.5f) * (1.f / 256.f); g[3] = ((float)(w.x >> 24) + 0.5f) * (1.f / 256.f);
    g[4] = ((float)(w.y & 255u) + 0.5f) * (1.f / 256.f); g[5] = ((float)((w.y >> 8) & 255u) + 0.5f) * (1.f / 256.f); g[6] = ((float)((w.y >> 16) & 255u) + 0.5f) * (1.f / 256.f); g[7] = ((float)(w.y >> 24) + 0.5f) * (1.f / 256.f);
}
struct EpiGates { static constexpr bool PERM = true, AFTER_DRAIN = false, SEG2 = false, MID = false;
    unsigned char* G;
    __device__ __forceinline__ void operator()(AccRef acc, const Unit& u, int wr, int wc, int fr, int fq) const {
        EPI_ROWS_BEGIN
        EPI_COLS_BEGIN
            u32x2 w; w.x = gq8(v0[0]) | (gq8(v0[1]) << 8) | (gq8(v0[2]) << 16) | (gq8(v0[3]) << 24); w.y = gq8(v1[0]) | (gq8(v1[1]) << 8) | (gq8(v1[2]) << 16) | (gq8(v1[3]) << 24);
            *(u32x2*)(G + gtile_off(u.pm, u.pn, wr, wc, fr, fq, ai, m, bj)) = w;
        EPI_END
    }
};
namespace pg8 { template <> struct epi_fp8<EpiGates> { static constexpr bool v = true; }; }
struct EpiMerge { static constexpr bool PERM = true, AFTER_DRAIN = false, SEG2 = true, MID = true;
    const unsigned char* G; bf16* M;
    __device__ __forceinline__ void mid(f32x4 (&acc)[2][2][4][2], const Unit& u, int t, int wr, int wc, int fr, int fq) const {
        const int bra = (t == 8) ? 0 : 1;
        u32x2 ra[2][4][2], rb[2][4][2];
#pragma unroll
        for (int ai = 0; ai < 2; ++ai)
#pragma unroll
            for (int m = 0; m < 4; ++m)
#pragma unroll
                for (int bj = 0; bj < 2; ++bj) { ra[ai][m][bj] = *(const u32x2*)(G + gtile_off(u.pm, bra * 4 + u.pn, wr, wc, fr, fq, ai, m, bj)); rb[ai][m][bj] = *(const u32x2*)(G + gtile_off(u.pm, (bra + 1) * 4 + u.pn, wr, wc, fr, fq, ai, m, bj)); }
        asm volatile("" ::: "memory");
#pragma unroll
        for (int ai = 0; ai < 2; ++ai)
#pragma unroll
            for (int m = 0; m < 4; ++m)
#pragma unroll
                for (int bj = 0; bj < 2; ++bj) { float ga[8], gb[8]; gdq8(ra[ai][m][bj], ga); gdq8(rb[ai][m][bj], gb);
#pragma unroll
                    for (int e = 0; e < 8; ++e) ga[e] = ga[e] * __builtin_amdgcn_rcpf(gb[e]);
                    acc[ai][bj][m][0] *= (f32x4){ga[0], ga[1], ga[2], ga[3]}; acc[ai][bj][m][1] *= (f32x4){ga[4], ga[5], ga[6], ga[7]}; }
    }
    __device__ __forceinline__ void operator()(AccRef acc, const Unit& u, int wr, int wc, int fr, int fq) const {
        EPIB_BEGIN
            u32x2 gr[4];
            EPIB_ITEMS gr[it4] = *(const u32x2*)(G + gtile_off(u.pm, 8 + u.pn, wr, wc, fr, fq, ai, m, bj)); EPIB_FENCE
            EPIB_ITEMS const f32x4 v0 = acc[ai][bj][m][0], v1 = acc[ai][bj][m][1];
                float g[8]; gdq8(gr[it4], g);
                const float o[8] = {g[0] * v0[0], g[1] * v0[1], g[2] * v0[2], g[3] * v0[3], g[4] * v1[0], g[5] * v1[1], g[6] * v1[2], g[7] * v1[3]};
                *(u32x4*)(M + (size_t)(u.pm * 256 + trow) * 1024 + u.pn * 256 + cc) = pack8(o); }
        EPIB_END
    }
};
struct EpiWout { static constexpr bool PERM = true, AFTER_DRAIN = false, SEG2 = false, MID = false;
    const void* xin_lat; const float* xin_ctx; bf16* xo_lat; float* xo_ctx; const float* modl; int inbf;
    __device__ __forceinline__ void operator()(AccRef acc, const Unit& u, int wr, int wc, int fr, int fq) const {
        const int b = u.pm / TPB, t = u.pm - b * TPB; const bool isctx = (t == 0), rdbf = !isctx && inbf;
        const size_t lrow0 = (size_t)(b * SEQ + (isctx ? 0 : t - 1) * 256);
        const float* xi = isctx ? xin_ctx + (size_t)(b * CTX) * DM : (const float*)xin_lat + lrow0 * DM;
        const bf16* xib = (const bf16*)xin_lat + lrow0 * DM;
        float* xo = xo_ctx + (size_t)(b * CTX) * DM; bf16* xob = xo_lat + lrow0 * DM;
        const float* g1 = modl + (size_t)((isctx ? 8 : b) * 6 + 2) * DM + u.pn * 256 + wc * 32 + 8 * fq;
        f32x4 gg[2][2];
#pragma unroll
        for (int bj = 0; bj < 2; ++bj) { gg[bj][0] = *(const f32x4*)(g1 + bj * 128); gg[bj][1] = *(const f32x4*)(g1 + bj * 128 + 4); }
        EPIB_BEGIN
            f32x4 xa[4], xb[4];
            EPIB_ITEMS const size_t eo = (size_t)trow * DM + u.pn * 256 + cc;
                if (rdbf) { const u32x4 r = *(const u32x4*)(xib + eo); xa[it4] = __builtin_bit_cast(f32x4, r); xb[it4] = xa[it4]; }
                else { xa[it4] = *(const f32x4*)(xi + eo); xb[it4] = *(const f32x4*)(xi + eo + 4); } EPIB_FENCE
            EPIB_ITEMS const size_t eo = (size_t)trow * DM + u.pn * 256 + cc; f32x4 x0 = xa[it4], x1 = xb[it4];
                if (rdbf) { float t8[8]; unpack8(__builtin_bit_cast(u32x4, xa[it4]), t8); x0 = (f32x4){t8[0], t8[1], t8[2], t8[3]}; x1 = (f32x4){t8[4], t8[5], t8[6], t8[7]}; }
                const f32x4 y0 = x0 + gg[bj][0] * acc[ai][bj][m][0], y1 = x1 + gg[bj][1] * acc[ai][bj][m][1];
                if (isctx) { *(f32x4*)(xo + eo) = y0; *(f32x4*)(xo + eo + 4) = y1; }
                else { u32x4 w; w.x = cvt_pk_bf16(y0[0], y0[1]); w.y = cvt_pk_bf16(y0[2], y0[3]); w.z = cvt_pk_bf16(y1[0], y1[1]); w.w = cvt_pk_bf16(y1[2], y1[3]); *(u32x4*)(xob + eo) = w; } }
        EPIB_END
    }
};
struct EpiRouter { static constexpr bool PERM = true, AFTER_DRAIN = false, SEG2 = false, MID = false;
    float* RT;
    __device__ __forceinline__ void operator()(AccRef acc, const Unit& u, int wr, int wc, int fr, int fq) const {
        EPI_ROWS_BEGIN const int row = u.pm * 256 + trow;
        EPI_COLS_BEGIN
            if (cc < 64) { *(f32x4*)(RT + (size_t)row * 64 + cc) = v0; *(f32x4*)(RT + (size_t)row * 64 + cc + 4) = v1; }
        EPI_END
    }
};
struct EpiS5E { static constexpr bool PERM = true, AFTER_DRAIN = false, SEG2 = false, MID = false;
    float* E;
    __device__ __forceinline__ void operator()(AccRef acc, const Unit& u, int wr, int wc, int fr, int fq) const {
        const int g = u.pm / 5, rt = u.pm - g * 5;
        EPI_ROWS_BEGIN const int crow = rt * 256 + trow;
        EPI_COLS_BEGIN
            if (crow < NCHT) { float* ep = E + ((size_t)(g * NCHT + crow)) * 256 + cc; *(f32x4*)ep = v0; *(f32x4*)(ep + 4) = v1; }
        EPI_END
    }
};
struct EpiS5Out { static constexpr bool PERM = true, AFTER_DRAIN = false, SEG2 = false, MID = false;
    const bf16* AG; const float* dvec; bf16* Z;
    __device__ __forceinline__ void operator()(AccRef acc, const Unit& u, int wr, int wc, int fr, int fq) const {
        const int g = u.pm / 5, rt = u.pm - g * 5, ct = u.pn - g * 4;
        f32x4 dd[2][2];
#pragma unroll
        for (int bj = 0; bj < 2; ++bj) { const int h0 = (bj * 128 + wc * 32 + 8 * fq) & 15; dd[bj][0] = *(const f32x4*)(dvec + g * 16 + h0); dd[bj][1] = *(const f32x4*)(dvec + g * 16 + h0 + 4); }
        EPIB_BEGIN
            u32x4 ur[4];
            EPIB_ITEMS const int crow = rt * 256 + trow; ur[it4] = *(const u32x4*)(AG + ((size_t)(g * SROWS + crow)) * SLD + ct * 256 + cc); EPIB_FENCE
            EPIB_ITEMS const int crow = rt * 256 + trow; const f32x4 v0 = acc[ai][bj][m][0], v1 = acc[ai][bj][m][1];
                if (crow < NCHT) { const int ncol = ct * 256 + cc, j = ncol >> 4, h0 = ncol & 15; float uu[8]; unpack8(ur[it4], uu);
                    float o[8] = {v0[0] + dd[bj][0][0] * uu[0], v0[1] + dd[bj][0][1] * uu[1], v0[2] + dd[bj][0][2] * uu[2], v0[3] + dd[bj][0][3] * uu[3], v1[0] + dd[bj][1][0] * uu[4], v1[1] + dd[bj][1][1] * uu[5], v1[2] + dd[bj][1][2] * uu[6], v1[3] + dd[bj][1][3] * uu[7]};
#pragma unroll
                    for (int e = 0; e < 8; ++e) o[e] = fgelu_tanh(o[e]);
                    *(u32x4*)(Z + ((size_t)crow * 64 + j) * 512 + g * 16 + h0) = pack8(o); } }
        EPIB_END
    }
};
struct EpiGlu { static constexpr bool PERM = true, AFTER_DRAIN = false, SEG2 = false, MID = false;
    bf16* Z; const float* bias;
    __device__ __forceinline__ void operator()(AccRef acc, const Unit& u, int wr, int wc, int fr, int fq) const {
        f32x4 bb[2][2];
#pragma unroll
        for (int bj = 0; bj < 2; ++bj) { const float* bp = bias + bj * 128 + wc * 32 + 8 * fq; bb[bj][0] = *(const f32x4*)bp; bb[bj][1] = *(const f32x4*)(bp + 4); }
        EPIB_BEGIN
            u32x4 zr[4];
            EPIB_ITEMS zr[it4] = *(const u32x4*)(Z + (size_t)(u.pm * 256 + trow) * 512 + cc); EPIB_FENCE
            EPIB_ITEMS const f32x4 v0 = acc[ai][bj][m][0] + bb[bj][0], v1 = acc[ai][bj][m][1] + bb[bj][1]; float z[8]; unpack8(zr[it4], z);
                const float o[8] = {z[0] * fsigmoid(v0[0]), z[1] * fsigmoid(v0[1]), z[2] * fsigmoid(v0[2]), z[3] * fsigmoid(v0[3]), z[4] * fsigmoid(v1[0]), z[5] * fsigmoid(v1[1]), z[6] * fsigmoid(v1[2]), z[7] * fsigmoid(v1[3])};
                *(u32x4*)(Z + (size_t)(u.pm * 256 + trow) * 512 + cc) = pack8(o); }
        EPIB_END
    }
};
struct EpiMoe1 { static constexpr bool PERM = true, AFTER_DRAIN = false, SEG2 = false, MID = false;
    bf16* HH;
    __device__ __forceinline__ void operator()(AccRef acc, const Unit& u, int wr, int wc, int fr, int fq) const {
        const int ct = u.pn & 3;
        EPI_ROWS_BEGIN const size_t slot = (size_t)u.pm * 256 + trow;
        EPI_COLS_BEGIN
            u32x2 w; w.x = cvt_pk_bf16(fsilu(v0[0]) * v1[0], fsilu(v0[1]) * v1[1]); w.y = cvt_pk_bf16(fsilu(v0[2]) * v1[2], fsilu(v0[3]) * v1[3]);
            *(u32x2*)(HH + slot * 512 + ct * 128 + (cc >> 3) * 4) = w;
        EPI_END
    }
};
template <int PASS> struct EpiMoe2 { static constexpr bool PERM = true, AFTER_DRAIN = false, SEG2 = false, MID = false;
    const int* slot_row; const float* slot_w; bf16* xs_lat; float *xo_f32, *xo_ctx; const float* modl; bf16* T; float scale; int outf;
    __device__ __forceinline__ void operator()(AccRef acc, const Unit& u, int wr, int wc, int fr, int fq) const {
        const int ct = u.pn & 3, colb = ct * 256 + wc * 32 + 8 * fq;
        EPIB_BEGIN
            int tok[2]; float wgt[2];
#pragma unroll
            for (int mm = 0; mm < 2; ++mm) { const int slot = u.pm * 256 + ai * 128 + wr * 64 + (mh * 2 + mm) * 16 + fr; tok[mm] = slot_row[slot]; wgt[mm] = slot_w[slot] * scale; }
            if constexpr (PASS == 0) {
                EPIB_ITEMS if (tok[mm] >= 0) { const f32x4 v0 = acc[ai][bj][m][0] * wgt[mm], v1 = acc[ai][bj][m][1] * wgt[mm];
                    u32x4 w; w.x = cvt_pk_bf16(v0[0], v0[1]); w.y = cvt_pk_bf16(v0[2], v0[3]); w.z = cvt_pk_bf16(v1[0], v1[1]); w.w = cvt_pk_bf16(v1[2], v1[3]);
                    *(u32x4*)(T + (size_t)tok[mm] * DM + colb + bj * 128) = w; } }
            } else {
                f32x4 xa[4], xb[4], ga[4], gb[4]; u32x4 tr[4]; size_t eo[4]; bool ic[4];
                EPIB_ITEMS const int tk = tok[mm] < 0 ? 0 : tok[mm]; const int b = tk / RB, rr = tk - b * RB; const bool isctx = rr < CTX; ic[it4] = isctx;
                    eo[it4] = (isctx ? (size_t)(b * CTX + rr) : (size_t)(b * SEQ + rr - CTX)) * DM + colb + bj * 128;
                    const float* g2 = modl + (size_t)((isctx ? 8 : b) * 6 + 5) * DM + colb + bj * 128;
                    if (isctx) { xa[it4] = *(const f32x4*)(xo_ctx + eo[it4]); xb[it4] = *(const f32x4*)(xo_ctx + eo[it4] + 4); }
                    else { const u32x4 r = *(const u32x4*)(xs_lat + eo[it4]); xa[it4] = __builtin_bit_cast(f32x4, r); xb[it4] = xa[it4]; }
                    ga[it4] = *(const f32x4*)g2; gb[it4] = *(const f32x4*)(g2 + 4);
                    tr[it4] = *(const u32x4*)(T + (size_t)tk * DM + colb + bj * 128); EPIB_FENCE
                EPIB_ITEMS if (tok[mm] >= 0) { float t8[8]; unpack8(tr[it4], t8);
                    const f32x4 y0 = (f32x4){t8[0], t8[1], t8[2], t8[3]} + acc[ai][bj][m][0] * wgt[mm], y1 = (f32x4){t8[4], t8[5], t8[6], t8[7]} + acc[ai][bj][m][1] * wgt[mm];
                    f32x4 x0 = xa[it4], x1 = xb[it4];
                    if (!ic[it4]) { float x8[8]; unpack8(__builtin_bit_cast(u32x4, xa[it4]), x8); x0 = (f32x4){x8[0], x8[1], x8[2], x8[3]}; x1 = (f32x4){x8[4], x8[5], x8[6], x8[7]}; }
                    const f32x4 z0 = x0 + ga[it4] * y0, z1 = x1 + gb[it4] * y1;
                    if (ic[it4]) { *(f32x4*)(xo_ctx + eo[it4]) = z0; *(f32x4*)(xo_ctx + eo[it4] + 4) = z1; }
                    else if (outf) { *(f32x4*)(xo_f32 + eo[it4]) = z0; *(f32x4*)(xo_f32 + eo[it4] + 4) = z1; }
                    else { u32x4 w; w.x = cvt_pk_bf16(z0[0], z0[1]); w.y = cvt_pk_bf16(z0[2], z0[3]); w.z = cvt_pk_bf16(z1[0], z1[1]); w.w = cvt_pk_bf16(z1[2], z1[3]); *(u32x4*)(xs_lat + eo[it4]) = w; } } }
            }
        EPIB_END
    }
};

constexpr size_t al256(size_t x) { return (x + 255) & ~(size_t)255; }
constexpr size_t WS_CTL = 0, CTL_BYTES = 1u << 20;
constexpr size_t WS_MOD  = CTL_BYTES;                 constexpr size_t SZ_MOD  = 2ull * 9 * 6 * DM * 4;
constexpr size_t WS_ROPE = WS_MOD + al256(SZ_MOD);    constexpr size_t SZ_ROPE = 2ull * SEQ * 32 * 4;
constexpr size_t WS_MISC = WS_ROPE + al256(SZ_ROPE);  constexpr size_t SZ_MISC = 8192;
constexpr size_t WS_POW  = WS_MISC + SZ_MISC;         constexpr size_t SZ_POW  = 2ull * 2 * 16 * 64 * 65 * 8;
constexpr size_t WS_BBAR = WS_POW + al256(SZ_POW);    constexpr size_t SZ_BBAR = 2ull * 2 * 16 * 64 * 16 * 8;
constexpr size_t WS_KC   = WS_BBAR + al256(SZ_BBAR);  constexpr size_t SZ_KC   = 2ull * 16 * 64 * 256 * 4;
constexpr size_t WS_ASG  = WS_KC + al256(SZ_KC);      constexpr size_t SZ_ASG  = 3ull * R * 2 * 4;
constexpr size_t WS_SLOT = WS_ASG + al256(SZ_ASG);    constexpr size_t SZ_SLOT = 2ull * NSLOT * 4;
constexpr size_t WS_TILE = WS_SLOT + al256(SZ_SLOT);  constexpr size_t SZ_TILE = 8192;
constexpr size_t WS_WIN  = WS_TILE + SZ_TILE;         constexpr size_t SZ_WIN  = 6144ull * 1024 * 2;
constexpr size_t WS_WOA  = WS_WIN + SZ_WIN;           constexpr size_t SZ_WOA  = 1024ull * 512 * 2;
constexpr size_t WS_WOS  = WS_WOA + SZ_WOA;           constexpr size_t SZ_WOS  = 1024ull * 256 * 2;
constexpr size_t WS_WOH  = WS_WOS + SZ_WOS;           constexpr size_t SZ_WOH  = 1024ull * 256 * 2;
constexpr size_t WS_WOUT = WS_WOH + SZ_WOH;           constexpr size_t SZ_WOUT = 1024ull * 1024 * 2;
constexpr size_t WS_WGLU = WS_WOUT + SZ_WOUT;         constexpr size_t SZ_WGLU = 256ull * 256 * 2;
constexpr size_t WS_WRT  = WS_WGLU + SZ_WGLU;         constexpr size_t SZ_WRT  = 256ull * 1024 * 2;
constexpr size_t WS_WGU  = WS_WRT + SZ_WRT;           constexpr size_t SZ_WGU  = 32ull * 1024 * 1024 * 2;
constexpr size_t WS_WDN  = WS_WGU + SZ_WGU;           constexpr size_t SZ_WDN  = 32ull * 1024 * 512 * 2;
constexpr size_t WS_WTOT = WS_WDN + SZ_WDN;           constexpr size_t SZ_WTOT = 16ull * 1024 * SLD * 2;
constexpr size_t WS_WE   = WS_WTOT + SZ_WTOT;         constexpr size_t SZ_WE   = 16ull * 256 * 1024 * 2;
constexpr size_t WS_RA   = WS_WE + SZ_WE;             constexpr size_t SZ_RA   = (size_t)R * 3072 * 2;
constexpr size_t OFF_Q = 0, OFF_K = (size_t)R * 512 * 2, OFF_V = 2 * OFF_K, OFF_H5 = 3 * OFF_K;
static_assert(OFF_H5 + 5ull * R * 256 * 2 <= SZ_RA && (size_t)NSLOT * 1024 * 2 <= SZ_RA, "region A");
constexpr size_t WS_HX   = WS_RA + SZ_RA;             constexpr size_t SZ_HX   = (size_t)R * 1024 * 2;
constexpr size_t WS_XS   = WS_HX + SZ_HX;             constexpr size_t SZ_Y    = (size_t)R * 1024 * 2;
constexpr size_t WS_Y    = 0;
static_assert(SZ_Y <= (size_t)NB * SEQ * DM * 4 && (size_t)NB * SEQ * DM * 2 <= SZ_Y, "y buffers fit d_out; the bf16 stream fits the old y region");
constexpr size_t OFF_YS = (size_t)R * 512 * 2, OFF_YH = OFF_YS + (size_t)R * 256 * 2;
static_assert(16ull * SROWS * SLD * 2 <= OFF_YS, "AG aliases y_att");
constexpr size_t WS_RB   = WS_XS + SZ_Y;              constexpr size_t SZ_RB   = (size_t)NSLOT * 512 * 2;
static_assert(64ull * NCH * 4096 * 4 <= SZ_RB && (size_t)R * 1024 * 2 <= SZ_RB, "region B");
constexpr size_t WS_E    = WS_RB + SZ_RB;             constexpr size_t SZ_E    = 16ull * NCHT * 256 * 4;
static_assert((size_t)R * 64 * 4 <= SZ_E, "router logits alias E");
constexpr size_t WS_DEC  = WS_E + SZ_E;               constexpr size_t SZ_DEC  = 64ull * NCH * 64 * 4;
constexpr size_t WS_CTXS = WS_DEC + al256(SZ_DEC);    constexpr size_t SZ_CTXS = (size_t)NB * CTX * DM * 4;
constexpr size_t WS_END  = WS_CTXS + SZ_CTXS;
static_assert(WS_END <= (1ull << 30), "workspace map exceeds 1 GiB");
constexpr int CW_BAR = 4096;
constexpr int CW_GCNT = 16384;

constexpr int RING_BYTES = 131072;
constexpr int MISC_OFF = RING_BYTES + 320;
constexpr int LDS_BYTES = 147456;
#define LDS_WAIT() asm volatile("s_waitcnt lgkmcnt(0)" ::: "memory")
#define VM_WAIT() asm volatile("s_waitcnt vmcnt(0)" ::: "memory")

#define XB_TMO      128
#define XB_XCNT(j)  (256  + 64 * (j))
#define XB_XSUB(j)  (1280 + 64 * (j))
#define XB_XGEN(j)  (2304 + 64 * (j))
#define XB_TOP      3328
#define XB_TOPGEN   3392
#define XCD_BAR_WORDS 3456
#define XB_SPIN_CAP (1u << 18)
__device__ __forceinline__ unsigned xb_ld(unsigned* p)              { return __hip_atomic_load(p, __ATOMIC_RELAXED, __HIP_MEMORY_SCOPE_AGENT); }
__device__ __forceinline__ unsigned xb_add(unsigned* p, unsigned v) { return __hip_atomic_fetch_add(p, v, __ATOMIC_RELAXED, __HIP_MEMORY_SCOPE_AGENT); }
__device__ __forceinline__ unsigned xb_xcc_id() { return (unsigned)__builtin_amdgcn_s_getreg((3 << 11) | 20) & 0xFu; }
#define XB_SPIN(cond, bar) do { unsigned _sp = 0; while (cond) { __builtin_amdgcn_s_sleep(1); \
    if ((++_sp & 255u) == 0u) { if (xb_ld(&(bar)[XB_TMO])) break; if (_sp > XB_SPIN_CAP) { atomicAdd(&(bar)[XB_TMO], 1u); break; } } } } while (0)
struct XcdBarrier { unsigned* bar; unsigned x; volatile LAS unsigned* st; };
__device__ __forceinline__ XcdBarrier xcd_barrier_post(unsigned* bar, volatile LAS unsigned* st, const int wv) {
    XcdBarrier b; b.bar = bar; b.x = xb_xcc_id(); b.st = st;
    if (wv == 0 && lane_id() == 0) (void)xb_add(&bar[XB_XCNT(b.x)], 1u);
    return b;
}
__device__ __forceinline__ void xcd_barrier_complete(unsigned* bar, unsigned x, unsigned& nloc, unsigned& nx) {
    const unsigned G = gridDim.x * gridDim.y * gridDim.z;
    unsigned sum, cnt, mine, sp = 0u;
    for (;;) {
        sum = 0u; cnt = 0u; mine = 0u;
#pragma unroll
        for (unsigned j = 0; j < 16; ++j) { const unsigned c = xb_ld(&bar[XB_XCNT(j)]); sum += c; cnt += (c > 0u) ? 1u : 0u; mine = (j == x) ? c : mine; }
        if (sum == G) break;
        __builtin_amdgcn_s_sleep(1);
        if ((++sp & 255u) == 0u) { if (xb_ld(&bar[XB_TMO])) break; if (sp > XB_SPIN_CAP) { atomicAdd(&bar[XB_TMO], 1u); break; } }
    }
    nloc = mine > 0u ? mine : 1u; nx = cnt > 0u ? cnt : 1u;
}
__device__ __forceinline__ void xcd_barrier(const XcdBarrier& b, const int wv) {
    asm volatile("s_waitcnt vmcnt(0)" ::: "memory");
    __syncthreads();
    if (wv == 0 && lane_id() == 0) {
        unsigned* bar = b.bar;
        __builtin_amdgcn_s_waitcnt(0);
        unsigned nloc = b.st[0], nx = b.st[1];
        if (nloc == 0u) { xcd_barrier_complete(bar, b.x, nloc, nx); b.st[0] = nloc; b.st[1] = nx; }
        const unsigned old = xb_add(&bar[XB_XSUB(b.x)], 1u);
        const unsigned gen = old / nloc;
        if (old + 1u == (gen + 1u) * nloc) {
            __builtin_amdgcn_fence(__ATOMIC_RELEASE, "agent");
            asm volatile("s_waitcnt vmcnt(0)" ::: "memory");
            const unsigned og = xb_add(&bar[XB_TOP], 1u);
            const unsigned tg = og / nx;
            if (og + 1u == (tg + 1u) * nx) xb_add(&bar[XB_TOPGEN], 1u);
            else XB_SPIN(xb_ld(&bar[XB_TOPGEN]) == tg, bar);
            __builtin_amdgcn_fence(__ATOMIC_ACQUIRE, "agent");
            xb_add(&bar[XB_XGEN(b.x)], 1u);
            asm volatile("s_waitcnt vmcnt(0)" ::: "memory");
        } else {
            XB_SPIN(xb_ld(&bar[XB_XGEN(b.x)]) == gen, bar);
            __builtin_amdgcn_fence(__ATOMIC_ACQUIRE, "agent");
            asm volatile("s_waitcnt vmcnt(0)" ::: "memory");
        }
    }
    __syncthreads();
}

__device__ __forceinline__ void ti_load(const float* W, int N, int item, int lane, float (&wv_)[32]);
template <class RM> __device__ __forceinline__ void ti_store(const float (&wv_)[32], int K, int N, bf16* WT, LAS float* scr, int item, int lane, RM rm, int ldw);
template <class RM> __device__ __forceinline__ void transpose_item(const float* W, int K, int N, bf16* WT, LAS float* scr, int item, int lane, RM rm, int ldw = 0) {
    float wv_[32];
    ti_load(W, N, item, lane, wv_);
    ti_store(wv_, K, N, WT, scr, item, lane, rm, ldw);
}
__device__ __forceinline__ void ti_load(const float* W, int N, int item, int lane, float (&wv_)[32]) {
    const int nblk = N / 32, kb = item / nblk, nb = item % nblk, k0 = 64 * kb, n0 = 32 * nb;
#pragma unroll
    for (int i = 0; i < 32; ++i) wv_[i] = W[(size_t)(k0 + 2 * i + (lane >> 5)) * N + n0 + (lane & 31)];
}
template <class RM> __device__ __forceinline__ void ti_store(const float (&wv_)[32], int K, int N, bf16* WT, LAS float* scr, int item, int lane, RM rm, int ldw) {
    if (ldw == 0) ldw = K;
    const int nblk = N / 32, kb = item / nblk, nb = item % nblk, k0 = 64 * kb, n0 = 32 * nb;
#pragma unroll
    for (int i = 0; i < 32; ++i) scr[(2 * i + (lane >> 5)) * 33 + (lane & 31)] = wv_[i];
    LDS_WAIT(); asm volatile("" ::: "memory");
    const int c = lane & 7;
#pragma unroll
    for (int j = 0; j < 4; ++j) { const int n = (lane >> 3) + 8 * j; const LAS float* s = scr + (8 * c) * 33 + n;
        u32x4 o; o.x = cvt_pk_bf16(s[0 * 33], s[1 * 33]); o.y = cvt_pk_bf16(s[2 * 33], s[3 * 33]); o.z = cvt_pk_bf16(s[4 * 33], s[5 * 33]); o.w = cvt_pk_bf16(s[6 * 33], s[7 * 33]);
        *(u32x4*)(WT + (size_t)rm(n0 + n) * ldw + k0 + 8 * c) = o; }
    LDS_WAIT(); asm volatile("" ::: "memory");
}
template <class RM> __device__ __forceinline__ void transpose_item_f8(const float* W, int K, int N, unsigned char* WT, LAS float* scr, int item, int lane, RM rm, float scl) {
    const int nblk = N / 32, kb = item / nblk, nb = item % nblk, k0 = 64 * kb, n0 = 32 * nb;
    float wv_[32];
#pragma unroll
    for (int i = 0; i < 32; ++i) wv_[i] = W[(size_t)(k0 + 2 * i + (lane >> 5)) * N + n0 + (lane & 31)];
#pragma unroll
    for (int i = 0; i < 32; ++i) scr[(2 * i + (lane >> 5)) * 33 + (lane & 31)] = wv_[i];
    LDS_WAIT(); asm volatile("" ::: "memory");
    const int c = lane & 7;
#pragma unroll
    for (int j = 0; j < 4; ++j) { const int n = (lane >> 3) + 8 * j; const LAS float* s = scr + (8 * c) * 33 + n;
        int lo = 0, hi = 0; lo = __builtin_amdgcn_cvt_pk_fp8_f32(s[0 * 33] * scl, s[1 * 33] * scl, lo, false); lo = __builtin_amdgcn_cvt_pk_fp8_f32(s[2 * 33] * scl, s[3 * 33] * scl, lo, true);
        hi = __builtin_amdgcn_cvt_pk_fp8_f32(s[4 * 33] * scl, s[5 * 33] * scl, hi, false); hi = __builtin_amdgcn_cvt_pk_fp8_f32(s[6 * 33] * scl, s[7 * 33] * scl, hi, true);
        *(u32x2*)(WT + (size_t)rm(n0 + n) * K + k0 + 8 * c) = (u32x2){(unsigned)lo, (unsigned)hi}; }
    LDS_WAIT(); asm volatile("" ::: "memory");
}
struct RmPlain { int off; __device__ __forceinline__ int operator()(int n) const { return off + n; } };
struct RmWin { __device__ __forceinline__ int operator()(int n) const {
    if (n >= 512 && n < 1024) { const int c = n - 512, sl = c >> 6, d = c & 63; return 512 + (sl >> 2) * 256 + ((d < 32) ? 32 * (sl & 3) + d : 128 + 32 * (sl & 3) + d - 32); }
    return (n >= 1024 && n < 1536) ? n + 1536 : (n >= 1536 && n < 3072) ? n - 512 : n; } };
struct RmGateUp { int add; __device__ __forceinline__ int operator()(int hid) const { return (hid >> 7) * 256 + ((hid & 127) >> 2) * 8 + (hid & 3) + add; } };

struct Ins { const float* p[36]; };
typedef const __attribute__((address_space(4))) Ins& InsK;
enum { I_X = 0, I_C, I_CTX, I_CCTX, I_ADAW, I_ADAB, I_NMIX, I_NFFN, I_WIN, I_QG, I_KG, I_DLAM, I_SUBLN, I_ARE, I_AIM, I_LOGDT, I_BRE, I_BIM, I_CRE, I_CIM, I_S5D, I_GLUW, I_GLUB,
       I_LB, I_HGN, I_WOA, I_WOS, I_WOH, I_WOUT, I_MWG, I_MBG, I_MWE, I_MBE, I_MGATE, I_MUP, I_MDOWN };

__device__ __forceinline__ void convert_weights(InsK in, unsigned char* ws, int l, LAS unsigned char* lds, int gw, int NGW, int wave, int lane) {
    LAS float* scr = (LAS float*)(lds + wave * 16384);
    constexpr int N_WIN = 16 * 192, N_WOA = 8 * 32, N_WOS = 4 * 32, N_WOUT = 16 * 32, N_GLU = 4 * 8, N_RTE = 16, N_RTG = 16, N_GU = 32 * 256, N_DN = 32 * 256;
    constexpr int TOTAL = N_WIN + N_WOA + 2 * N_WOS + N_WOUT + N_GLU + N_RTE + N_RTG + 2 * N_GU + N_DN;
    for (int it = gw; it < TOTAL - (2 * N_GU + N_DN); it += NGW) {
        int r = it;
        if (r < N_WIN) { transpose_item_f8(in.p[I_WIN] + (size_t)l * 1024 * 6144, 1024, 6144, ws + WS_WIN, scr, r, lane, RmWin{}, (r % 192 >= 96) ? -16.f * LOG2E : 16.f); continue; } r -= N_WIN;
        if (r < N_WOA) { transpose_item(in.p[I_WOA] + (size_t)l * 512 * 1024, 512, 1024, (bf16*)(ws + WS_WOA), scr, r, lane, RmPlain{0}, 1024); continue; } r -= N_WOA;
        if (r < N_WOS) { transpose_item(in.p[I_WOS] + (size_t)l * 256 * 1024, 256, 1024, (bf16*)(ws + WS_WOA) + 512, scr, r, lane, RmPlain{0}, 1024); continue; } r -= N_WOS;
        if (r < N_WOS) { transpose_item(in.p[I_WOH] + (size_t)l * 256 * 1024, 256, 1024, (bf16*)(ws + WS_WOA) + 768, scr, r, lane, RmPlain{0}, 1024); continue; } r -= N_WOS;
        if (r < N_WOUT) { transpose_item(in.p[I_WOUT] + (size_t)l * 1024 * 1024, 1024, 1024, (bf16*)(ws + WS_WOUT), scr, r, lane, RmPlain{0}); continue; } r -= N_WOUT;
        if (r < N_GLU) { transpose_item(in.p[I_GLUW] + (size_t)l * 256 * 256, 256, 256, (bf16*)(ws + WS_WGLU), scr, r, lane, RmPlain{0}); continue; } r -= N_GLU;
        if (r < N_RTE) { transpose_item(in.p[I_MWE] + (size_t)l * 1024 * 32, 1024, 32, (bf16*)(ws + WS_WRT), scr, r, lane, RmPlain{0}); continue; } r -= N_RTE;
        if (r < N_RTG) { const float* wg = in.p[I_MWG] + (size_t)l * 1024 * 4; bf16* wt = (bf16*)(ws + WS_WRT); const int k = r * 64 + lane;
#pragma unroll
            for (int g = 0; g < 4; ++g) wt[(size_t)(32 + g) * 1024 + k] = f2bf(wg[k * 4 + g]);
            continue; } r -= N_RTG;
    }
    constexpr int NE = 2 * N_GU + N_DN;
#define CW_SRC(r_) ((r_) < N_GU ? in.p[I_MGATE] + ((size_t)l * 32 + ((r_) >> 8)) * 1024 * 512 : (r_) < 2 * N_GU ? in.p[I_MUP] + ((size_t)l * 32 + (((r_) - N_GU) >> 8)) * 1024 * 512 : in.p[I_MDOWN] + ((size_t)l * 32 + (((r_) - 2 * N_GU) >> 8)) * 512 * 1024)
    int r = (gw + NGW - (TOTAL - NE) % NGW) % NGW;
    float cur_[32], nxt_[32];
    if (r < NE) ti_load(CW_SRC(r), r < 2 * N_GU ? 512 : 1024, r & 255, lane, cur_);
    while (r < NE) { const int rn = r + NGW, rl = rn < NE ? rn : r;
        ti_load(CW_SRC(rl), rl < 2 * N_GU ? 512 : 1024, rl & 255, lane, nxt_);
        if (r < N_GU) { const int e = r >> 8; ti_store(cur_, 1024, 512, (bf16*)(ws + WS_WGU) + (size_t)e * 1024 * 1024, scr, r & 255, lane, RmGateUp{0}, 0); }
        else if (r < 2 * N_GU) { const int e = (r - N_GU) >> 8; ti_store(cur_, 1024, 512, (bf16*)(ws + WS_WGU) + (size_t)e * 1024 * 1024, scr, r & 255, lane, RmGateUp{4}, 0); }
        else { const int e = (r - 2 * N_GU) >> 8; ti_store(cur_, 512, 1024, (bf16*)(ws + WS_WDN) + (size_t)e * 1024 * 512, scr, r & 255, lane, RmPlain{0}, 0); }
#pragma unroll
        for (int i = 0; i < 32; ++i) cur_[i] = nxt_[i];
        r = rn; }
#undef CW_SRC
}

__device__ __forceinline__ void norm_rows(const void* x_lat, int latbf  , const float* x_ctx, const float* gain, const float* modl, int which, bf16* HX, int gw, int NGW, int lane, bool f8out = false  ) {
    for (int row0 = gw; row0 < R; row0 += 2 * NGW) {
        f32x4 v[2][4]; const float* shp[2]; bool ok[2];
#pragma unroll
        for (int u = 0; u < 2; ++u) { const int row = row0 + u * NGW; ok[u] = row < R; const int rw = ok[u] ? row : row0; const int b = rw / RB, rr = rw - b * RB; const bool isctx = rr < CTX;
            shp[u] = modl + (size_t)((isctx ? 8 : b) * 6 + which * 3) * DM;
            if (!isctx && latbf) { const bf16* xr = (const bf16*)x_lat + (size_t)(b * SEQ + rr - CTX) * DM;
#pragma unroll
                for (int j = 0; j < 4; ++j) { const u32x2 r = *(const u32x2*)(xr + 256 * j + 4 * lane);
                    v[u][j] = (f32x4){__builtin_bit_cast(float, r.x << 16), __builtin_bit_cast(float, r.x & 0xffff0000u), __builtin_bit_cast(float, r.y << 16), __builtin_bit_cast(float, r.y & 0xffff0000u)}; } }
            else { const float* xr = isctx ? x_ctx + (size_t)(b * CTX + rr) * DM : (const float*)x_lat + (size_t)(b * SEQ + rr - CTX) * DM;
#pragma unroll
                for (int j = 0; j < 4; ++j) v[u][j] = *(const f32x4*)(xr + 256 * j + 4 * lane); } }
#pragma unroll
        for (int u = 0; u < 2; ++u) { float s = 0.f;
#pragma unroll
            for (int j = 0; j < 4; ++j) s += (v[u][j].x * v[u][j].x + v[u][j].y * v[u][j].y) + (v[u][j].z * v[u][j].z + v[u][j].w * v[u][j].w);
            const float rinv = __builtin_amdgcn_rsqf(wave_sum(s, lane) * (1.f / DM) + RMS_EPS);
            if (ok[u]) { const int row = row0 + u * NGW; const float* sh = shp[u]; const float* sc = sh + DM;
#pragma unroll
                for (int j = 0; j < 4; ++j) { const int c = 256 * j + 4 * lane; const f32x4 g = *(const f32x4*)(gain + c), a = *(const f32x4*)(sc + c), d = *(const f32x4*)(sh + c);
                    const f32x4 y = v[u][j] * rinv * g * (a + 1.f) + d;
                    if (f8out) { int w8 = 0; w8 = __builtin_amdgcn_cvt_pk_fp8_f32(y.x * 4.f, y.y * 4.f, w8, false); w8 = __builtin_amdgcn_cvt_pk_fp8_f32(y.z * 4.f, y.w * 4.f, w8, true); *(int*)((unsigned char*)HX + (size_t)row * DM + c) = w8; }
                    else { u32x2 w; w.x = cvt_pk_bf16(y.x, y.y); w.y = cvt_pk_bf16(y.z, y.w); *(u32x2*)(HX + (size_t)row * DM + c) = w; } } } }
    }
}

__device__ __forceinline__ void norm_mix(const void* x_lat, int latbf, const float* x_ctx, const float* gain, const float* modl, unsigned char* HX8, LAS unsigned char* lds, int vcu, int G, int wv, int tid, int lane) {
    const int r_lo = (int)((long long)vcu * R / G), r_hi = (int)((long long)(vcu + 1) * R / G);
    const int b_lo = r_lo / RB;
    for (int i = tid; i < 3 * 256; i += 512) { const int slot = i >> 8, c = i & 255; const int set = slot == 2 ? 8 : min(b_lo + slot, 7);
        const f32x4 g4 = *(const f32x4*)(gain + 4 * c), d4 = *(const f32x4*)(modl + (size_t)(set * 6 + 0) * DM + 4 * c), a4 = *(const f32x4*)(modl + (size_t)(set * 6 + 1) * DM + 4 * c);
        f32x4 gp4; gp4[0] = 4.f * (g4[0] * (a4[0] + 1.f)); gp4[1] = 4.f * (g4[1] * (a4[1] + 1.f)); gp4[2] = 4.f * (g4[2] * (a4[2] + 1.f)); gp4[3] = 4.f * (g4[3] * (a4[3] + 1.f));
        *(LAS f32x4*)(lds + slot * 8192 + c * 16) = gp4; *(LAS f32x4*)(lds + slot * 8192 + 4096 + c * 16) = d4 * 4.f; }
    __syncthreads();
    const int nrw = (r_hi - r_lo - wv + 7) >> 3;
    const int nit = (nrw + 3) >> 2;
    u32x4 cur[4][4], nxt[4][4];
#define NM_LOAD(buf, it_) { _Pragma("unroll") for (int u = 0; u < 4; ++u) { const int k_ = min(4 * (it_) + u, nrw - 1); const int row = r_lo + wv + 8 * k_; const int b = row / RB, rr = row - b * RB; const bool isctx = rr < CTX; \
        if (!isctx && latbf) { const bf16* xr = (const bf16*)x_lat + (size_t)(b * SEQ + rr - CTX) * DM + 4 * lane; _Pragma("unroll") for (int j = 0; j < 4; ++j) { const u32x2 r2 = *(const u32x2*)(xr + 256 * j); buf[u][j].x = r2.x; buf[u][j].y = r2.y; } } \
        else { const float* xr = (isctx ? x_ctx + (size_t)(b * CTX + rr) * DM : (const float*)x_lat + (size_t)(b * SEQ + rr - CTX) * DM) + 4 * lane; _Pragma("unroll") for (int j = 0; j < 4; ++j) buf[u][j] = *(const u32x4*)(xr + 256 * j); } } }
    if (nit > 0) NM_LOAD(cur, 0)
    for (int it = 0; it < nit; ++it) {
        NM_LOAD(nxt, min(it + 1, nit - 1))
#pragma unroll
        for (int u = 0; u < 4; ++u) { const int k = 4 * it + u; const int kc = min(k, nrw - 1); const int row = r_lo + wv + 8 * kc; const int b = row / RB, rr = row - b * RB; const bool isctx = rr < CTX;
            f32x4 v[4];
            if (!isctx && latbf) {
#pragma unroll
                for (int j = 0; j < 4; ++j) { const unsigned rx = cur[u][j].x, ry = cur[u][j].y; v[j] = (f32x4){__builtin_bit_cast(float, rx << 16), __builtin_bit_cast(float, rx & 0xffff0000u), __builtin_bit_cast(float, ry << 16), __builtin_bit_cast(float, ry & 0xffff0000u)}; } }
            else {
#pragma unroll
                for (int j = 0; j < 4; ++j) v[j] = __builtin_bit_cast(f32x4, cur[u][j]); }
            float sq = 0.f;
#pragma unroll
            for (int j = 0; j < 4; ++j) sq += (v[j].x * v[j].x + v[j].y * v[j].y) + (v[j].z * v[j].z + v[j].w * v[j].w);
            const float rinv = __builtin_amdgcn_rsqf(wave_sum(sq, lane) * (1.f / DM) + RMS_EPS);
            if (k < nrw) { const LAS unsigned char* pl = lds + (isctx ? 2 : b - b_lo) * 8192 + lane * 16;
#pragma unroll
                for (int j = 0; j < 4; ++j) { const f32x4 g = *(const LAS f32x4*)(pl + 4096 * 0 + 1024 * j), d = *(const LAS f32x4*)(pl + 4096 + 1024 * j);
                    const f32x4 y = v[j] * rinv * g + d;
                    int w8 = 0; w8 = __builtin_amdgcn_cvt_pk_fp8_f32(y.x, y.y, w8, false); w8 = __builtin_amdgcn_cvt_pk_fp8_f32(y.z, y.w, w8, true); *(int*)(HX8 + (size_t)row * DM + 256 * j + 4 * lane) = w8; } } }
#pragma unroll
        for (int u = 0; u < 4; ++u)
#pragma unroll
            for (int j = 0; j < 4; ++j) cur[u][j] = nxt[u][j];
    }
#undef NM_LOAD
}

__device__ __forceinline__ void norm_route(const bf16* x_lat, const float* x_ctx, const float* gain, const float* modl, bf16* HX, const bf16* WRT, const float* bE, const float* bG,
                                           int* asg_gid, int* asg_pos, float* asg_w, unsigned* gcnt, LAS unsigned char* lds, bool skip_ctx, int vcu, int G, int wv, int tid, int lane) {
    constexpr int WST = 2064;
    constexpr int POFF = 36 * WST;
    constexpr int SOFF = POFF + 3 * 8192;
    constexpr int COFF = SOFF + 8 * 2368;
    constexpr int IOFF = COFF + 512;
    constexpr int NGRP = R / 16;
    const int g_lo = (int)((long long)vcu * NGRP / G), g_hi = (int)((long long)(vcu + 1) * NGRP / G);
    const int b_lo = (g_lo * 16) / RB;
    LAS unsigned* lcnt = (LAS unsigned*)(lds + COFF); LAS unsigned* lbase = lcnt + 64; LAS unsigned* rinfo = (LAS unsigned*)(lds + IOFF);
    for (int i = tid; i < 36 * 128; i += 512) { const int row = i >> 7, ch = i & 127; *(LAS u32x4*)(lds + row * WST + ch * 16) = *(const u32x4*)(WRT + (size_t)row * 1024 + ch * 8); }
    for (int i = tid; i < 3 * 256; i += 512) { const int slot = i >> 8, c = i & 255; const int set = slot == 2 ? 8 : min(b_lo + slot, 7);
        const f32x4 g4 = *(const f32x4*)(gain + 4 * c), d4 = *(const f32x4*)(modl + (size_t)(set * 6 + 3) * DM + 4 * c), a4 = *(const f32x4*)(modl + (size_t)(set * 6 + 4) * DM + 4 * c);
        f32x4 gp4; gp4[0] = g4[0] * (a4[0] + 1.f); gp4[1] = g4[1] * (a4[1] + 1.f); gp4[2] = g4[2] * (a4[2] + 1.f); gp4[3] = g4[3] * (a4[3] + 1.f);
        *(LAS f32x4*)(lds + POFF + slot * 8192 + c * 16) = gp4; *(LAS f32x4*)(lds + POFF + slot * 8192 + 4096 + c * 16) = d4; }
    if (tid < 64) lcnt[tid] = 0u;
    __syncthreads();
    const int r16 = lane & 15, q = lane >> 4;
    LAS float* scr = (LAS float*)(lds + SOFF + wv * 2368);
    for (int gi = g_lo + wv; gi < g_hi; gi += 8) {
        const int row = gi * 16 + r16; const int b = row / RB, rr = row - b * RB; const bool isctx = rr < CTX;
        const int rl = (gi - g_lo) * 16 + lane;
        if (skip_ctx && isctx) { if (lane < 16) { int neg = -1; asm volatile("" : "+v"(neg)); asg_gid[(gi * 16 + lane) * 2] = neg; asg_gid[(gi * 16 + lane) * 2 + 1] = neg; rinfo[rl * 2] = 0u; } continue; }
        u32x4 raw[32];
        if (isctx) { const float* xr = x_ctx + (size_t)(b * CTX + rr) * DM + 8 * q;
#pragma unroll
            for (int s_ = 0; s_ < 32; ++s_) { const f32x4 a = *(const f32x4*)(xr + 32 * s_), c = *(const f32x4*)(xr + 32 * s_ + 4);
                raw[s_].x = cvt_pk_bf16(a[0], a[1]); raw[s_].y = cvt_pk_bf16(a[2], a[3]); raw[s_].z = cvt_pk_bf16(c[0], c[1]); raw[s_].w = cvt_pk_bf16(c[2], c[3]); if ((s_ & 7) == 7) __builtin_amdgcn_sched_barrier(0); } }
        else { const bf16* xr = x_lat + (size_t)(b * SEQ + rr - CTX) * DM + 8 * q;
#pragma unroll
            for (int s_ = 0; s_ < 32; ++s_) raw[s_] = *(const u32x4*)(xr + 32 * s_); }
        float ss = 0.f;
#pragma unroll
        for (int s_ = 0; s_ < 32; ++s_) { float t8[8]; unpack8(raw[s_], t8);
#pragma unroll
            for (int e = 0; e < 8; ++e) ss += t8[e] * t8[e]; }
        ss += shx(ss, 16, lane); ss += shx(ss, 32, lane);
#pragma unroll
        for (int s_ = 0; s_ < 32; ++s_) asm volatile("" : "+v"(raw[s_]));
        const float rinv = __builtin_amdgcn_rsqf(ss * (1.f / DM) + RMS_EPS);
        const LAS unsigned char* pl = lds + POFF + (isctx ? 2 : b - b_lo) * 8192 + q * 32;
        f32x4 acc[3] = {{0.f, 0.f, 0.f, 0.f}, {0.f, 0.f, 0.f, 0.f}, {0.f, 0.f, 0.f, 0.f}};
        const unsigned hoff = (unsigned)row * 2048u + 16u * (unsigned)q;
        const LAS unsigned char* wl = lds + r16 * WST + q * 16;
        const LAS unsigned char* wl2 = lds + (r16 < 4 ? 32 + r16 : r16) * WST + q * 16;
#pragma unroll
        for (int s_ = 0; s_ < 32; ++s_) { float t8[8], y[8]; unpack8(raw[s_], t8);
            const f32x4 g0 = *(const LAS f32x4*)(pl + 128 * s_), g1 = *(const LAS f32x4*)(pl + 128 * s_ + 16), d0 = *(const LAS f32x4*)(pl + 4096 + 128 * s_), d1 = *(const LAS f32x4*)(pl + 4096 + 128 * s_ + 16);
#pragma unroll
            for (int e = 0; e < 4; ++e) { y[e] = t8[e] * rinv * g0[e] + d0[e]; y[4 + e] = t8[4 + e] * rinv * g1[e] + d1[e]; }
            const u32x4 w = pack8(y); *(u32x4*)((unsigned char*)HX + (hoff + 64u * s_)) = w;
            const bf16x8 af = __builtin_bit_cast(bf16x8, w);
            const bf16x8 b0 = *(const LAS bf16x8*)(wl + s_ * 64), b1 = *(const LAS bf16x8*)(wl + 16 * WST + s_ * 64), b2 = *(const LAS bf16x8*)(wl2 + s_ * 64);
            acc[0] = __builtin_amdgcn_mfma_f32_16x16x32_bf16(af, b0, acc[0], 0, 0, 0); acc[1] = __builtin_amdgcn_mfma_f32_16x16x32_bf16(af, b1, acc[1], 0, 0, 0); acc[2] = __builtin_amdgcn_mfma_f32_16x16x32_bf16(af, b2, acc[2], 0, 0, 0);
            if (s_ & 1) __builtin_amdgcn_sched_barrier(0); }
#pragma unroll
        for (int i = 0; i < 4; ++i) { scr[(4 * q + i) * 37 + r16] = acc[0][i]; scr[(4 * q + i) * 37 + 16 + r16] = acc[1][i]; if (r16 < 4) scr[(4 * q + i) * 37 + 32 + r16] = acc[2][i]; }
        __builtin_amdgcn_fence(__ATOMIC_RELEASE, "wavefront"); __builtin_amdgcn_wave_barrier(); __builtin_amdgcn_fence(__ATOMIC_ACQUIRE, "wavefront");
        if (lane < 16) {
            const LAS float* lr = scr + lane * 37;
            const float lg[4] = {lr[32] + bG[0], lr[33] + bG[1], lr[34] + bG[2], lr[35] + bG[3]};
            int gs = 0; float gm = lg[0];
#pragma unroll
            for (int k = 1; k < 4; ++k) if (lg[k] > gm) { gm = lg[k]; gs = k; }
            float zs = 0.f;
#pragma unroll
            for (int k = 0; k < 4; ++k) zs += __expf(lg[k] - gm);
            const float pg = 1.f / zs;
            float le[8];
#pragma unroll
            for (int k = 0; k < 8; ++k) le[k] = lr[gs * 8 + k] + bE[gs * 8 + k];
            int i0 = 0; float m0 = le[0];
#pragma unroll
            for (int k = 1; k < 8; ++k) if (le[k] > m0) { m0 = le[k]; i0 = k; }
            int i1 = -1; float m1 = -3.0e38f;
#pragma unroll
            for (int k = 0; k < 8; ++k) if (k != i0 && le[k] > m1) { m1 = le[k]; i1 = k; }
            const float e1 = __expf(m1 - m0); const float w0 = pg / (1.f + e1), w1 = pg * e1 / (1.f + e1);
            const int gid0 = gs * 8 + i0, gid1 = 32 + gs * 8 + i1;
            const unsigned rk0 = __hip_atomic_fetch_add(&lcnt[gid0], 1u, __ATOMIC_RELAXED, __HIP_MEMORY_SCOPE_WORKGROUP);
            const unsigned rk1 = __hip_atomic_fetch_add(&lcnt[gid1], 1u, __ATOMIC_RELAXED, __HIP_MEMORY_SCOPE_WORKGROUP);
            const int rowg = gi * 16 + lane;
            asg_gid[rowg * 2] = gid0; asg_gid[rowg * 2 + 1] = gid1; asg_w[rowg * 2] = w0; asg_w[rowg * 2 + 1] = w1;
            rinfo[rl * 2] = 0x10000u | (unsigned)gid0 | ((unsigned)gid1 << 8); rinfo[rl * 2 + 1] = rk0 | (rk1 << 16);
        }
        __builtin_amdgcn_wave_barrier();
    }
    __syncthreads();
    if (tid < 64) { const unsigned n = lcnt[tid]; lbase[tid] = n ? __hip_atomic_fetch_add(&gcnt[tid], n, __ATOMIC_RELAXED, __HIP_MEMORY_SCOPE_AGENT) : 0u; }
    __syncthreads();
    for (int rl = tid; rl < (g_hi - g_lo) * 16; rl += 512) { const unsigned i0 = rinfo[rl * 2], i1 = rinfo[rl * 2 + 1];
        if (i0 & 0x10000u) { const int rowg = g_lo * 16 + rl; asg_pos[rowg * 2] = (int)(lbase[i0 & 63u] + (i1 & 0xffffu)); asg_pos[rowg * 2 + 1] = (int)(lbase[(i0 >> 8) & 63u] + (i1 >> 16)); } }
}

__device__ __forceinline__ void mod_vectors(InsK in, float* MOD, LAS unsigned char* lds, int G, int tid, int wave, int lane) {
    LAS float* cact = (LAS float*)lds;
    LAS float* part = (LAS float*)(lds + 9 * 1024 * 4);
    for (int i = tid; i < 9 * 1024; i += 512) { const int bi = i >> 10, k = i & 1023; const float c = bi < 8 ? in.p[I_C][bi * 1024 + k] : in.p[I_CCTX][k]; cact[i] = fsilu(c); }
    __syncthreads();
    for (int u = blockIdx.x; u < 2 * 96; u += G) {
        const int l = u / 96, col = (u - l * 96) * 64 + lane;
        const float* w = in.p[I_ADAW] + (size_t)l * 1024 * 6144 + col;
        float acc[9];
#pragma unroll
        for (int bi = 0; bi < 9; ++bi) acc[bi] = 0.f;
        for (int k = wave * 128; k < wave * 128 + 128; ++k) { const float wv = w[(size_t)k * 6144];
#pragma unroll
            for (int bi = 0; bi < 9; ++bi) acc[bi] += cact[bi * 1024 + k] * wv; }
#pragma unroll
        for (int bi = 0; bi < 9; ++bi) part[(wave * 9 + bi) * 64 + lane] = acc[bi];
        __syncthreads();
        for (int i = tid; i < 9 * 64; i += 512) { const int bi = i >> 6, c = i & 63; float s = 0.f;
#pragma unroll
            for (int w8 = 0; w8 < 8; ++w8) s += part[(w8 * 9 + bi) * 64 + c];
            const int cg = (u - l * 96) * 64 + c; MOD[((size_t)l * 9 + bi) * 6144 + cg] = s + in.p[I_ADAB][l * 6144 + cg]; }
        __syncthreads();
    }
}
__device__ __forceinline__ void small_tables(InsK in, unsigned char* ws, int gtid, int NT) {
    float* rope = (float*)(ws + WS_ROPE);
    for (int i = gtid; i < SEQ * 32; i += NT) { const int t = i >> 5, a = i & 31; const float inv = powf(10000.f, -(float)(a & 15) / 16.f);
        const float ang = (float)(a < 16 ? (t >> 6) : (t & 63)) * inv; rope[i] = cosf(ang); rope[SEQ * 32 + i] = sinf(ang); }
    float* misc = (float*)(ws + WS_MISC);
    for (int i = gtid; i < 2 * 256; i += NT) { const float a0 = in.p[I_LB][i], a1 = in.p[I_LB][512 + i]; const float mx = fmaxf(a0, a1), e0 = expf(a0 - mx), e1 = expf(a1 - mx);
        misc[i] = 0.f; misc[512 + i] = e1 / (e0 + e1); }
    if (gtid < 2) { const int l = gtid; const float* lv = in.p[I_DLAM] + l * 256; float s01 = 0.f, s23 = 0.f;
        for (int k = 0; k < 64; ++k) { s01 += lv[k] * lv[64 + k]; s23 += lv[128 + k] * lv[192 + k]; }
        const float lam_init = 0.8f - 0.6f * expf(-0.3f * (float)l); misc[1024 + l] = expf(s01) - expf(s23) + lam_init; misc[1026 + l] = lam_init; }
    float* POW = (float*)(ws + WS_POW); float* BB = (float*)(ws + WS_BBAR);
    for (int i = gtid; i < 2 * 2 * 16 * 64 * 65; i += NT) { const int n = i % 65, q = i / 65, p = q & 63, g = (q >> 6) & 15, d = (q >> 10) & 1, l = q >> 11;
        const int ai = ((l * 2 + d) * 16 + g) * 64 + p; const double dt = exp((double)in.p[I_LOGDT][(l * 2 + d) * 16 + g]);
        const double are = (double)in.p[I_ARE][ai] * dt * n, aim = (double)in.p[I_AIM][ai] * dt * n, mag = exp(are);
        POW[2 * (size_t)i] = (float)(mag * cos(aim)); POW[2 * (size_t)i + 1] = (float)(mag * sin(aim)); }
    for (int i = gtid; i < 2 * 2 * 16 * 64; i += NT) { const int p = i & 63, g = (i >> 6) & 15, d = (i >> 10) & 1, l = i >> 11;
        const double dt = exp((double)in.p[I_LOGDT][(l * 2 + d) * 16 + g]), ar = in.p[I_ARE][i], aim = in.p[I_AIM][i];
        const double mag = exp(ar * dt), lr = mag * cos(aim * dt) - 1.0, li = mag * sin(aim * dt), den = ar * ar + aim * aim;
        const double cr = (lr * ar + li * aim) / den, ci = (li * ar - lr * aim) / den;
        const float* bre = in.p[I_BRE] + ((size_t)(l * 16 + g) * 64 + p) * 16; const float* bim = in.p[I_BIM] + ((size_t)(l * 16 + g) * 64 + p) * 16;
        for (int h = 0; h < 16; ++h) { const double br = bre[h], bi = bim[h]; BB[((size_t)i * 16 + h) * 2] = (float)(cr * br - ci * bi); BB[((size_t)i * 16 + h) * 2 + 1] = (float)(cr * bi + ci * br); } }
}
__device__ __forceinline__ void s5_compact(InsK in, unsigned char* ws, int l, LAS unsigned char* lds, int G, int tid) {
    LAS float* T = (LAS float*)lds;
    LAS float* Bs = (LAS float*)(lds + 16 * 64 * 2 * 4);
    const float* POW = (const float*)(ws + WS_POW); const float* BB = (const float*)(ws + WS_BBAR); float* KC = (float*)(ws + WS_KC);
    for (int it = blockIdx.x; it < 2 * 16 * 64; it += G) {
        const int n = it & 63, g = (it >> 6) & 15, d = it >> 10;
        for (int i = tid; i < 1024; i += 512) { const int hp = i >> 6, p = i & 63;
            const float cr = in.p[I_CRE][((size_t)(l * 16 + g) * 16 + hp) * 64 + p], ci = in.p[I_CIM][((size_t)(l * 16 + g) * 16 + hp) * 64 + p];
            const size_t pi = ((((size_t)(l * 2 + d) * 16 + g) * 64 + p) * 65 + n) * 2; const float pr = POW[pi], pim = POW[pi + 1];
            T[i * 2] = cr * pr - ci * pim; T[i * 2 + 1] = cr * pim + ci * pr; }
        for (int i = tid; i < 1024; i += 512) { const size_t bi = (((size_t)(l * 2 + d) * 16 + g) * 64) * 16 + i; Bs[i * 2] = BB[bi * 2]; Bs[i * 2 + 1] = BB[bi * 2 + 1]; }
        __syncthreads();
        if (tid < 256) { const int hp = tid >> 4, h = tid & 15; float s = 0.f;
            for (int p = 0; p < 64; ++p) { const float tr = T[(hp * 64 + p) * 2], ti = T[(hp * 64 + p) * 2 + 1], br = Bs[(p * 16 + h) * 2], bi = Bs[(p * 16 + h) * 2 + 1]; s += tr * br - ti * bi; }
            KC[(((size_t)d * 16 + g) * 64 + n) * 256 + tid] = s; }
        __syncthreads();
    }
}
__device__ __forceinline__ void s5_expand(InsK in, unsigned char* ws, int l, int gtid, int NT) {
    const float* __restrict__ POW = (const float*)(ws + WS_POW); const float* __restrict__ BB = (const float*)(ws + WS_BBAR); const float* __restrict__ KC = (const float*)(ws + WS_KC);
    bf16* __restrict__ WT = (bf16*)(ws + WS_WTOT); bf16* __restrict__ WE = (bf16*)(ws + WS_WE);
    static_assert(SLD == 1280, "k layout: 1024 kernel taps | 128 fwd carry | 128 bwd carry");
    constexpr int NA = 16 * 1024 * 128, NBI = 16 * 1024 * 32, NC = 16 * 256 * 128;
    for (int it0 = gtid; it0 < NA; it0 += 4 * NT) {
        f32x4 a0[4], a1[4], b0[4], b1[4];
#pragma unroll
        for (int u = 0; u < 4; ++u) { const int it = min(it0 + u * NT, NA - 1); const int k8 = it & 127, q = it >> 7, nrow = q & 1023, g = q >> 10, j = nrow >> 4, hp = nrow & 15, k0 = k8 * 8, i = k0 >> 4, h0 = k0 & 15;
            const float* kf = KC + (((size_t)0 * 16 + g) * 64) * 256 + hp * 16 + h0; const float* kb = KC + (((size_t)1 * 16 + g) * 64) * 256 + hp * 16 + h0;
            const float* src = (i <= j) ? kf + (size_t)(j - i) * 256 : kb + (size_t)(i - j) * 256;
            a0[u] = *(const f32x4*)src; a1[u] = *(const f32x4*)(src + 4); b0[u] = *(const f32x4*)kb; b1[u] = *(const f32x4*)(kb + 4); }
#pragma unroll
        for (int u = 0; u < 4; ++u) { const int it = it0 + u * NT; if (it < NA) { const int k8 = it & 127, q = it >> 7, nrow = q & 1023, g = q >> 10, j = nrow >> 4, k0 = k8 * 8, i = k0 >> 4;
            const float m = (i == j) ? 1.f : 0.f;
            const float o[8] = {a0[u][0] + m * b0[u][0], a0[u][1] + m * b0[u][1], a0[u][2] + m * b0[u][2], a0[u][3] + m * b0[u][3], a1[u][0] + m * b1[u][0], a1[u][1] + m * b1[u][1], a1[u][2] + m * b1[u][2], a1[u][3] + m * b1[u][3]};
            *(u32x4*)(WT + ((size_t)g * 1024 + nrow) * SLD + k0) = pack8(o); } }
    }
    for (int it0 = gtid; it0 < NBI; it0 += 4 * NT) {
        float cr[4][4], ci[4][4], pr[4][4], pm[4][4];
#pragma unroll
        for (int u = 0; u < 4; ++u) { const int it = min(it0 + u * NT, NBI - 1); const int k8 = it & 31, q = it >> 5, nrow = q & 1023, g = q >> 10, j = nrow >> 4, hp = nrow & 15, k0 = 1024 + k8 * 8;
            const int d = (k0 >= 1152) ? 1 : 0, kk = k0 - 1024 - d * 128, n = d ? 64 - j : j + 1;
#pragma unroll
            for (int e = 0; e < 4; ++e) { const int p = (kk >> 1) + e;
                cr[u][e] = in.p[I_CRE][((size_t)(l * 16 + g) * 16 + hp) * 64 + p]; ci[u][e] = in.p[I_CIM][((size_t)(l * 16 + g) * 16 + hp) * 64 + p];
                const size_t pi = ((((size_t)(l * 2 + d) * 16 + g) * 64 + p) * 65 + n) * 2; pr[u][e] = POW[pi]; pm[u][e] = POW[pi + 1]; } }
#pragma unroll
        for (int u = 0; u < 4; ++u) { const int it = it0 + u * NT; if (it < NBI) { const int k8 = it & 31, q = it >> 5, nrow = q & 1023, g = q >> 10, k0 = 1024 + k8 * 8;
            float o[8];
#pragma unroll
            for (int e = 0; e < 4; ++e) { o[2 * e] = cr[u][e] * pr[u][e] - ci[u][e] * pm[u][e]; o[2 * e + 1] = -(cr[u][e] * pm[u][e] + ci[u][e] * pr[u][e]); }
            *(u32x4*)(WT + ((size_t)g * 1024 + nrow) * SLD + k0) = pack8(o); } }
    }
    for (int it0 = gtid; it0 < NC; it0 += 4 * NT) {
        f32x4 bbv[4][4]; float pr[4], pm[4];
#pragma unroll
        for (int u = 0; u < 4; ++u) { const int it = min(it0 + u * NT, NC - 1); const int k8 = it & 127, q = it >> 7, n = q & 255, g = q >> 8, d = n >> 7, p = (n & 127) >> 1, k0 = k8 * 8, i = k0 >> 4, h0 = k0 & 15;
            const int pw = d ? i : 63 - i; const size_t pi = ((((size_t)(l * 2 + d) * 16 + g) * 64 + p) * 65 + pw) * 2; pr[u] = POW[pi]; pm[u] = POW[pi + 1];
            const float* bb = BB + ((((size_t)(l * 2 + d) * 16 + g) * 64 + p) * 16 + h0) * 2;
#pragma unroll
            for (int v = 0; v < 4; ++v) bbv[u][v] = *(const f32x4*)(bb + 4 * v); }
#pragma unroll
        for (int u = 0; u < 4; ++u) { const int it = it0 + u * NT; if (it < NC) { const int k8 = it & 127, q = it >> 7, n = q & 255, g = q >> 8, ri = n & 1, k0 = k8 * 8;
            float o[8];
#pragma unroll
            for (int e = 0; e < 8; ++e) { const float br = bbv[u][e >> 1][(e & 1) * 2], bi = bbv[u][e >> 1][(e & 1) * 2 + 1]; o[e] = ri ? (pr[u] * bi + pm[u] * br) : (pr[u] * br - pm[u] * bi); }
            *(u32x4*)(WE + ((size_t)g * 256 + n) * 1024 + k0) = pack8(o); } }
    }
}

namespace att {
constexpr int SHM_V = 64 * 128 * 2, SHM_K = 64 * 128 * 2, SHM_V8 = 64 * 128, SHM_K8 = 64 * 128;
#define KSWZ(row, colB) ((row) * 256 + ((colB) ^ (((row) & 7) << 4)))
#define SBAR() __builtin_amdgcn_sched_barrier(0)
__device__ __forceinline__ int crow(int r, int hi) { return (r & 3) + 8 * (r >> 2) + 4 * hi; }
__device__ __forceinline__ void exp_half(f32x16& p) {
#pragma unroll
    for (int r = 0; r < 16; ++r) p[r] = __builtin_amdgcn_exp2f(p[r]);
}
typedef int v8i __attribute__((ext_vector_type(8)));
__device__ __forceinline__ int pk_u8x4(const f32x16& p, int base) { unsigned w = __builtin_bit_cast(unsigned, p[base + 1]);
    w = __builtin_amdgcn_cvt_pk_u8_f32(p[base], 0, w); w = __builtin_amdgcn_cvt_pk_u8_f32(p[base + 1], 1, w); w = __builtin_amdgcn_cvt_pk_u8_f32(p[base + 2], 2, w); w = __builtin_amdgcn_cvt_pk_u8_f32(p[base + 3], 3, w); return (int)w; }
template <int Q> __device__ __forceinline__ void sm_quarter(const f32x16& p0, int (&nb)[4]) { nb[Q] = pk_u8x4(p0, 4 * Q); }
__device__ __forceinline__ v8i finishSM2(const f32x16& p1, const int (&nb)[4]) {
    return v8i{nb[0], nb[1], nb[2], nb[3], pk_u8x4(p1, 0), pk_u8x4(p1, 4), pk_u8x4(p1, 8), pk_u8x4(p1, 12)};
}
__device__ __forceinline__ void qkt(f32x16& p0, f32x16& p1, const LAS char* Ks, const bf16x8* qr, int mapoff, int r32, int hi) {
    p0 = f32x16{}; p1 = f32x16{};
#pragma unroll
    for (int d0 = 0; d0 < 4; ++d0) { const int cb = (mapoff + d0 * 16 + hi * 8) * 2;
        const bf16x8 b0 = *reinterpret_cast<const LAS bf16x8*>(Ks + KSWZ(r32, cb));
        const bf16x8 b1 = *reinterpret_cast<const LAS bf16x8*>(Ks + KSWZ(32 + r32, cb));
        p0 = __builtin_amdgcn_mfma_f32_32x32x16_bf16(b0, qr[d0], p0, 0, 0, 0);
        p1 = __builtin_amdgcn_mfma_f32_32x32x16_bf16(b1, qr[d0], p1, 0, 0, 0); }
}
template <int G> __device__ __forceinline__ void kload1(u32x4* kq, const LAS char* Ks, int map, int r32, int hi) {
    const int row = r32 + 32 * (G >> 1), c = map * 4 + 2 * hi + (G & 1);
    kq[G] = *reinterpret_cast<const LAS u32x4*>(Ks + row * 128 + ((c ^ ((r32 >> 1) & 7)) << 4));
}
__device__ __forceinline__ void qk_mma(f32x16& p0, f32x16& p1, const u32x4* kq, const v8i q8, const f32x16& m5) {
    const v8i ka = {(int)kq[0].x, (int)kq[0].y, (int)kq[0].z, (int)kq[0].w, (int)kq[1].x, (int)kq[1].y, (int)kq[1].z, (int)kq[1].w};
    const v8i kb = {(int)kq[2].x, (int)kq[2].y, (int)kq[2].z, (int)kq[2].w, (int)kq[3].x, (int)kq[3].y, (int)kq[3].z, (int)kq[3].w};
    p0 = __builtin_amdgcn_mfma_scale_f32_32x32x64_f8f6f4(ka, q8, m5, 0, 0, 0, 0x7f7f7f7f, 0, (int)0x80808080u);
    p1 = __builtin_amdgcn_mfma_scale_f32_32x32x64_f8f6f4(kb, q8, m5, 0, 0, 0, 0x7f7f7f7f, 0, (int)0x80808080u);
}
struct VB { const LAS char *p0, *p1; };
__device__ __forceinline__ VB v_rd_bases(const LAS char* Vt, int lane) { const int r = lane & 31, hi = lane >> 5, sw = (r >> 2) & 3; const LAS char* b = Vt + r * 64;
    return VB{b + (((2 * hi) ^ sw) << 4), b + (((2 * hi + 1) ^ sw) << 4)}; }
struct AF { u32x4 lo, hi; };
template <int D0> __device__ __forceinline__ AF pv_load(const VB vb) { return AF{*(const LAS u32x4*)(vb.p0 + D0 * 2048), *(const LAS u32x4*)(vb.p1 + D0 * 2048)}; }
__device__ __forceinline__ void pv_mma(f32x16& od, const AF& f, const v8i pb) {
    const v8i a = {(int)f.lo.x, (int)f.lo.y, (int)f.lo.z, (int)f.lo.w, (int)f.hi.x, (int)f.hi.y, (int)f.hi.z, (int)f.hi.w};
    od = __builtin_amdgcn_mfma_scale_f32_32x32x64_f8f6f4(a, pb, od, 0, 0, 0, 0x7f7f7f7f, 0, 0x7f7f7f7f);
}
__device__ __forceinline__ void pv_ones(f32x16& ol, const v8i ones8, const v8i pb) { ol = __builtin_amdgcn_mfma_scale_f32_32x32x64_f8f6f4(ones8, pb, ol, 0, 0, 0, 0x7f7f7f7f, 0, 0x7f7f7f7f); }
__device__ __forceinline__ void pv_d0k(f32x16* o, f32x16& ol, const v8i ones8, const VB vb, const v8i pb, u32x4* kf, const LAS char* Ks, int mapoff, int r32, int hi, f32x16& y0, int (&nb)[4]) {
    const AF f0 = pv_load<0>(vb); SBAR();
    const AF f1 = pv_load<1>(vb); SBAR(); kload1<0>(kf, Ks, mapoff, r32, hi); sm_quarter<0>(y0, nb); pv_mma(o[0], f0, pb); SBAR();
    const AF f2 = pv_load<2>(vb); SBAR(); kload1<1>(kf, Ks, mapoff, r32, hi); sm_quarter<1>(y0, nb); pv_mma(o[1], f1, pb); SBAR();
    const AF f3 = pv_load<3>(vb); SBAR(); kload1<2>(kf, Ks, mapoff, r32, hi); sm_quarter<2>(y0, nb); pv_mma(o[2], f2, pb); pv_ones(ol, ones8, pb); SBAR();
    kload1<3>(kf, Ks, mapoff, r32, hi); sm_quarter<3>(y0, nb); pv_mma(o[3], f3, pb);
}
__device__ __forceinline__ void pv_d0(f32x16* o, f32x16& ol, const v8i ones8, const VB vb, const v8i pb) {
    const AF f0 = pv_load<0>(vb), f1 = pv_load<1>(vb); SBAR(); pv_mma(o[0], f0, pb); pv_ones(ol, ones8, pb);
    const AF f2 = pv_load<2>(vb); SBAR(); pv_mma(o[1], f1, pb);
    const AF f3 = pv_load<3>(vb); SBAR(); pv_mma(o[2], f2, pb); pv_mma(o[3], f3, pb);
}
__device__ __forceinline__ void diff_attn_unit(const bf16* __restrict__ Qb, const unsigned char* __restrict__ Kh, const unsigned char* __restrict__ Vh, bf16* __restrict__ Yb, int seq,
                                               float lam, float oscale, const float* __restrict__ subg, const float* __restrict__ qg, const float* __restrict__ rope, int qt0  , LAS char* lds, const int wv) {
    int lane_ = lane_id(); asm volatile("" : "+v"(lane_)); const int lane = lane_, wid = wv, tid = wv * 64 + lane, r32 = lane & 31, hi = lane >> 5, qblk = wid & 3, map = wid >> 2;
    LAS char* V_lds = lds; LAS char* K_lds = lds + 2 * SHM_V;
    f32x16 o[4] = {}, ol = {}; v8i q8;
    const int skk = tid >> 3, skc = tid & 7, kst0 = skk * 128 + ((skc ^ ((skk >> 1) & 7)) << 4);
    const int vdv = tid >> 2, vkc = tid & 3, vst0 = vdv * 64 + ((vkc ^ ((vdv >> 2) & 3)) << 4);
    const VB vbA = v_rd_bases(V_lds, lane), vbB = v_rd_bases(V_lds + SHM_V8, lane);
    f32x16 m5; { float tq = 0.75f; asm volatile("" : "+v"(tq)); float t5 = (__builtin_amdgcn_cvt_pk_u8_f32(tq, 0, 0u) & 255u) ? 8.f : 8.5f;
        asm volatile("" : "+v"(t5));
#pragma unroll
        for (int r = 0; r < 16; ++r) m5[r] = t5; }
    asm volatile("" : "+v"(m5));
    v8i ones8; { int t1 = 0x38383838; asm volatile("" : "+v"(t1));
#pragma unroll
        for (int r = 0; r < 8; ++r) ones8[r] = t1; }
    asm volatile("" : "+v"(ones8));
    const int mapoff = map;
    struct { bf16x8 vs0, ks0; } sr_[2];
    const unsigned go0 = (unsigned)(skk * 512 + skc * 16);
    const unsigned gv0 = (unsigned)(vdv * RB + vkc * 16);
    const __amdgpu_buffer_rsrc_t rsK = __builtin_amdgcn_make_buffer_rsrc((void*)Kh, (short)0, seq * 512, 0x00020000), rsV = __builtin_amdgcn_make_buffer_rsrc((void*)Vh, (short)0, 128 * RB, 0x00020000);
#define BLD(rs, vo, so) __builtin_bit_cast(bf16x8, __builtin_amdgcn_raw_buffer_load_b128(rs, (int)(vo), (int)(so), 0))
#define VLOAD(i, k0) do { sr_[i].vs0 = BLD(rsV, gv0, (k0)); } while (0)
#define KLOAD(i, k0) do { sr_[i].ks0 = BLD(rsK, go0, (k0) * 512); } while (0)
#define VWRITE(b, i) do { *(LAS bf16x8*)(V_lds + (b) * SHM_V8 + vst0) = sr_[i].vs0; } while (0)
#define KWRITE(b, i) do { *(LAS bf16x8*)(K_lds + (b) * SHM_K8 + kst0) = sr_[i].ks0; } while (0)
#define TCL(t) ((t) * 64)
#define KLOADF(Ks) do { kload1<0>(kf, Ks, mapoff, r32, hi); kload1<1>(kf, Ks, mapoff, r32, hi); kload1<2>(kf, Ks, mapoff, r32, hi); kload1<3>(kf, Ks, mapoff, r32, hi); } while (0)
    f32x16 pA0, pA1, pB0, pB1; u32x4 kf[4]; int nA[4], nB[4]; v8i pb; const int NT = seq / 64;
    VLOAD(0, 0); KLOAD(0, 0); KLOAD(1, TCL(1));
    const bf16x8 k2a = BLD(rsK, go0, TCL(2) * 512);
    SBAR();
    const bf16* Qw = Qb + (size_t)(qblk * 32 + r32) * 512 + map * 64 + hi * 8;
    {
        float qf[4][8]; float ss = 0.f;
#pragma unroll
        for (int d0 = 0; d0 < 4; ++d0) { const u32x4 raw = *reinterpret_cast<const u32x4*>(Qw + d0 * 16); unpack8(raw, qf[d0]);
#pragma unroll
            for (int j = 0; j < 8; ++j) ss += qf[d0][j] * qf[d0][j]; }
        { auto rr = __builtin_amdgcn_permlane32_swap(__float_as_uint(ss), __float_as_uint(ss), false, false); ss = __uint_as_float(rr[0]) + __uint_as_float(rr[1]); }
        const float rinv = __builtin_amdgcn_rsqf(ss * (1.f / 64.f) + RMS_EPS) * (0.125f * LOG2E);
#pragma unroll
        for (int d0 = 0; d0 < 4; ++d0) { const f32x4 ga = *(const f32x4*)(qg + d0 * 16 + hi * 8), gb = *(const f32x4*)(qg + d0 * 16 + hi * 8 + 4);
#pragma unroll
            for (int j = 0; j < 8; ++j) qf[d0][j] *= rinv * (j < 4 ? ga[j & 3] : gb[j & 3]); }
        if (qt0 >= 0) { const float* cs = rope + (size_t)(qt0 + qblk * 32 + r32) * 32 + hi * 8; const float* sn = cs + (size_t)SEQ * 32;
#pragma unroll
            for (int d0 = 0; d0 < 2; ++d0) { const f32x4 ca = *(const f32x4*)(cs + d0 * 16), cb = *(const f32x4*)(cs + d0 * 16 + 4), sa = *(const f32x4*)(sn + d0 * 16), sb = *(const f32x4*)(sn + d0 * 16 + 4);
#pragma unroll
                for (int j = 0; j < 8; ++j) { const float c = j < 4 ? ca[j & 3] : cb[j & 3], s = j < 4 ? sa[j & 3] : sb[j & 3], t1 = qf[d0][j], t2 = qf[d0 + 2][j]; qf[d0][j] = t1 * c - t2 * s; qf[d0 + 2][j] = t1 * s + t2 * c; } } }
#pragma unroll
        for (int d0 = 0; d0 < 4; ++d0) { int lo = 0, hi4 = 0;
            lo = __builtin_amdgcn_cvt_pk_fp8_f32(qf[d0][0] * 4.f, qf[d0][1] * 4.f, lo, false); lo = __builtin_amdgcn_cvt_pk_fp8_f32(qf[d0][2] * 4.f, qf[d0][3] * 4.f, lo, true);
            hi4 = __builtin_amdgcn_cvt_pk_fp8_f32(qf[d0][4] * 4.f, qf[d0][5] * 4.f, hi4, false); hi4 = __builtin_amdgcn_cvt_pk_fp8_f32(qf[d0][6] * 4.f, qf[d0][7] * 4.f, hi4, true);
            q8[2 * d0] = lo; q8[2 * d0 + 1] = hi4; }
    }
    VWRITE(0, 0); KWRITE(0, 0); KWRITE(1, 1);
    __syncthreads();
    VLOAD(1, TCL(1)); KLOAD(1, TCL(3)); VLOAD(0, TCL(2)); KLOAD(0, TCL(4));
    KLOADF(K_lds); qk_mma(pA0, pA1, kf, q8, m5); sm_quarter<0>(pA0, nA); sm_quarter<1>(pA0, nA); sm_quarter<2>(pA0, nA); sm_quarter<3>(pA0, nA); SBAR(); KLOADF(K_lds + SHM_K8);
    __syncthreads();
    *(LAS bf16x8*)(K_lds + kst0) = k2a;
    __syncthreads();
#define HALF(j, X0, X1, XN, Y0, Y1, YN, PB) do { \
        SBAR(); VWRITE(PB, PB); KWRITE(PB, PB); VLOAD(PB, TCL((j) + 2)); KLOAD(PB, TCL((j) + 4)); SBAR(); \
        qk_mma(Y0, Y1, kf, q8, m5); pb = finishSM2(X1, XN); SBAR(); \
        pv_d0k(o, ol, ones8, (PB) ? vbA : vbB, pb, kf, K_lds + (1 - PB) * SHM_K8, mapoff, r32, hi, Y0, YN); \
        __syncthreads(); } while (0)
    for (int j = 1; j + 1 < NT; j += 2) {
        HALF(j, pA0, pA1, nA, pB0, pB1, nB, 1);
        HALF(j + 1, pB0, pB1, nB, pA0, pA1, nA, 0);
    }
    HALF(NT - 1, pA0, pA1, nA, pB0, pB1, nB, 1);
    pb = finishSM2(pB1, nB); SBAR();
    pv_d0(o, ol, ones8, vbB, pb);
#undef HALF
#undef KLOADF
#undef TCL
#undef VLOAD
#undef BLD
#undef KLOAD
#undef VWRITE
#undef KWRITE
    const float rl = __builtin_amdgcn_rcpf(ol[0]);
    __syncthreads();
    LAS float* X = (LAS float*)lds + (size_t)qblk * 4096;
    if (map == 1) { const float sc1 = rl * lam;
#pragma unroll
        for (int d0 = 0; d0 < 4; ++d0)
#pragma unroll
            for (int r = 0; r < 16; ++r) X[(d0 * 16 + r) * 64 + lane] = o[d0][r] * sc1;
    }
    __syncthreads();
    if (map == 0) {
        float ssq = 0.f;
#pragma unroll
        for (int d0 = 0; d0 < 4; ++d0)
#pragma unroll
            for (int r = 0; r < 16; ++r) { const float v = o[d0][r] * rl - X[(d0 * 16 + r) * 64 + lane]; o[d0][r] = v; ssq += v * v; }
        { auto rr = __builtin_amdgcn_permlane32_swap(__float_as_uint(ssq), __float_as_uint(ssq), false, false); ssq = __uint_as_float(rr[0]) + __uint_as_float(rr[1]); }
        const float rn = __builtin_amdgcn_rsqf(ssq * (1.f / 128.f) + RMS_EPS) * oscale;
        bf16* Yw = Yb + (size_t)(qblk * 32 + r32) * 512 + 4 * hi;
#pragma unroll
        for (int d0 = 0; d0 < 4; ++d0)
#pragma unroll
            for (int g = 0; g < 4; ++g) { const f32x4 gs = *(const f32x4*)(subg + d0 * 32 + g * 8 + 4 * hi);
                u32x2 w; w.x = cvt_pk_bf16(o[d0][4 * g] * rn * gs[0], o[d0][4 * g + 1] * rn * gs[1]); w.y = cvt_pk_bf16(o[d0][4 * g + 2] * rn * gs[2], o[d0][4 * g + 3] * rn * gs[3]);
                *(u32x2*)(Yw + d0 * 32 + g * 8) = w; }
    }
    __syncthreads();
}
#undef KSWZ
#undef PK4
}

namespace hg {
constexpr int TS = 72;
constexpr int TILE_B = 64 * TS * 2;
constexpr int DIR_B = 49152;
constexpr int OUT_OFF = 98304;
__device__ __forceinline__ float clampf(float x, float lo, float hi) { return fminf(fmaxf(x, lo), hi); }
__device__ __forceinline__ f32x4 mm16(const LAS bf16* X, int mb, const LAS bf16* Y, int nb, f32x4 acc, int lane) {
    const int r = lane & 15, kq = (lane >> 4) * 8;
#pragma unroll
    for (int ks = 0; ks < 2; ++ks) { const bf16x8 a = *(const LAS bf16x8*)(X + (mb * 16 + r) * TS + ks * 32 + kq), b = *(const LAS bf16x8*)(Y + (nb * 16 + r) * TS + ks * 32 + kq);
        acc = __builtin_amdgcn_mfma_f32_16x16x32_bf16(a, b, acc, 0, 0, 0); }
    return acc;
}
struct Raw { unsigned rf[16], rv[16], rq[16]; f32x4 sraw[4]; u32x4 graw; };
struct Ptrs { const bf16 *HQ, *HFF, *HFB, *HI, *HGt; };
template <int MODE> __device__ __forceinline__ void load_unit(Raw& P, int b, int c, int hh, const Ptrs& Q, const float* ST, const int wv, const int lane) {
    const int wid = wv, tid = wv * 64 + lane, d = wid >> 2, tq = wid & 3, k = lane;
    const size_t r0 = (size_t)b * RB + (size_t)c * 64; const int ch = hh * 64 + k; const bf16* HF = d ? Q.HFB : Q.HFF; const size_t chain = (size_t)((b * 4 + hh) * 2 + d);
#pragma unroll
    for (int i = 0; i < 16; ++i) { const int jp = tq * 16 + i, j = d ? 63 - jp : jp; const size_t gi = (r0 + j) * 256 + ch; P.rf[i] = HF[gi]; P.rv[i] = Q.HI[gi]; if constexpr (MODE == 1) P.rq[i] = Q.HQ[gi]; }
    if constexpr (MODE == 1) { const int t = tid & 255, v = t >> 2, k0 = (t & 3) * 16; const float* sp = ST + (chain * NCH + c) * 4096 + v * 64 + k0;
#pragma unroll
        for (int q4 = 0; q4 < 4; ++q4) P.sraw[q4] = *(const f32x4*)(sp + q4 * 4);
        P.graw = *(const u32x4*)(Q.HGt + (r0 + (tid >> 3)) * 256 + hh * 64 + (tid & 7) * 8); }
}
template <int MODE> __device__ __forceinline__ void unit(Raw& P, int b, int c, int hh, bool has_next, int nb, int nc, int nhh, const Ptrs& Q, const float* lower  ,
                                                          const float* norm_g, float* ST, float* DEC, bf16* YH, LAS unsigned char* lds, const int wv, const int lane) {
    const int wid = wv, tid = wv * 64 + lane, d = wid >> 2, w4 = wid & 3, k = lane, tq = w4;
    LAS unsigned char* base = lds + d * DIR_B;
    LAS bf16* T0 = (LAS bf16*)base; LAS bf16* T1 = (LAS bf16*)(base + TILE_B); LAS bf16* T2 = (LAS bf16*)(base + 2 * TILE_B); LAS bf16* T3 = (LAS bf16*)(base + 3 * TILE_B); LAS bf16* T4 = (LAS bf16*)(base + 4 * TILE_B);
    LAS float* TOT = (LAS float*)(base + 5 * TILE_B);
    const size_t r0 = (size_t)b * RB + (size_t)c * 64; const int ch = hh * 64 + k;
    const float lb = lower[d * 256 + ch];
    const size_t chain = (size_t)((b * 4 + hh) * 2 + d);
    float lf[16], kk[16], qv[16], vv[16];
    asm volatile("" ::: "memory");
    float run = 0.f;
#pragma unroll
    for (int i = 0; i < 16; ++i) {
        const float fz = bf2f((bf16)P.rf[i]);
        const float te = fexp(fminf(-fz, 80.f));
        const float sg = __builtin_amdgcn_rcpf(1.f + te);
        run += __logf(lb + (1.f - lb) * sg); lf[i] = run;
        kk[i] = (1.f - lb) * te * sg;
        vv[i] = bf2f((bf16)P.rv[i]);
        if constexpr (MODE == 1) qv[i] = fsilu(bf2f((bf16)P.rq[i])); }
    TOT[tq * 64 + k] = run;
    __syncthreads();
    const float t0 = TOT[k], t1 = TOT[64 + k], t2 = TOT[128 + k], t3 = TOT[192 + k];
    const float off = (tq > 0 ? t0 : 0.f) + (tq > 1 ? t1 : 0.f) + (tq > 2 ? t2 : 0.f), bL = (t0 + t1) + (t2 + t3), beta = t0 + t1;
    { float t8[8];
#pragma unroll
      for (int h8 = 0; h8 < 2; ++h8) {
#pragma unroll
        for (int e = 0; e < 8; ++e) t8[e] = vv[h8 * 8 + e];
        *(LAS u32x4*)(T4 + k * TS + tq * 16 + h8 * 8) = pack8(t8); } }
    if constexpr (MODE == 0) {
        { float t8[8];
#pragma unroll
          for (int h8 = 0; h8 < 2; ++h8) {
#pragma unroll
            for (int e = 0; e < 8; ++e) { const int i = h8 * 8 + e; t8[e] = kk[i] * fexp(bL - (off + lf[i])); }
            *(LAS u32x4*)(T1 + k * TS + tq * 16 + h8 * 8) = pack8(t8); } }
        if (tq == 0) DEC[(chain * NCH + c) * 64 + k] = fexp(bL);
        if (has_next) load_unit<MODE>(P, nb, nc, nhh, Q, ST, wv, lane);
        __syncthreads();
        f32x4 acc[4];
#pragma unroll
        for (int nb = 0; nb < 4; ++nb) acc[nb] = mm16(T4, w4, T1, nb, (f32x4){0.f, 0.f, 0.f, 0.f}, lane);
        float* sp = ST + (chain * NCH + c) * 4096;
#pragma unroll
        for (int nb = 0; nb < 4; ++nb)
#pragma unroll
            for (int rg = 0; rg < 4; ++rg) sp[(w4 * 16 + (lane >> 4) * 4 + rg) * 64 + nb * 16 + (lane & 15)] = acc[nb][rg];
        __syncthreads();
    } else {
#pragma unroll
        for (int i = 0; i < 16; ++i) { const int jp = tq * 16 + i; const float bj = off + lf[i];
            T0[jp * TS + k] = f2bf(qv[i] * fexp(clampf(bj - beta, -80.f, 80.f)));
            T1[jp * TS + k] = f2bf(kk[i] * fexp(clampf(beta - bj, -80.f, 80.f)));
            T2[jp * TS + k] = f2bf(qv[i] * fexp(bj)); }
        { const int t = tid & 255, v = t >> 2, k0 = (t & 3) * 16;
#pragma unroll
          for (int h8 = 0; h8 < 2; ++h8) { const f32x4 a = P.sraw[h8 * 2], bq = P.sraw[h8 * 2 + 1]; const float t8[8] = {a[0], a[1], a[2], a[3], bq[0], bq[1], bq[2], bq[3]};
            *(LAS u32x4*)(T3 + v * TS + k0 + h8 * 8) = pack8(t8); } }
        const u32x4 graw_cur = P.graw;
        if (has_next) load_unit<MODE>(P, nb, nc, nhh, Q, ST, wv, lane);
        __syncthreads();
        const int mb = w4;
        f32x4 accO[4], accA[4];
#pragma unroll
        for (int nb = 0; nb < 4; ++nb) { accO[nb] = mm16(T2, mb, T3, nb, (f32x4){0.f, 0.f, 0.f, 0.f}, lane);
            accA[nb] = (f32x4){0.f, 0.f, 0.f, 0.f}; if (nb <= mb) accA[nb] = mm16(T0, mb, T1, nb, accA[nb], lane); }
#pragma unroll
        for (int nb = 0; nb < 4; ++nb)
#pragma unroll
            for (int rg = 0; rg < 4; ++rg) { const int jr = mb * 16 + (lane >> 4) * 4 + rg, sc = nb * 16 + (lane & 15); T0[jr * TS + sc] = f2bf(sc <= jr ? accA[nb][rg] : 0.f); }
        LDS_WAIT();
#pragma unroll
        for (int nb = 0; nb < 4; ++nb) accO[nb] = mm16(T0, mb, T4, nb, accO[nb], lane);
        LAS float* OUT = (LAS float*)(lds + OUT_OFF + d * 16384);
#pragma unroll
        for (int nb = 0; nb < 4; ++nb)
#pragma unroll
            for (int rg = 0; rg < 4; ++rg) { const int jp = mb * 16 + (lane >> 4) * 4 + rg, tok = d ? 63 - jp : jp; OUT[tok * 64 + nb * 16 + (lane & 15)] = accO[nb][rg]; }
        __syncthreads();
        { const int j = tid >> 3, v0 = (tid & 7) * 8; const LAS float* o0 = (const LAS float*)(lds + OUT_OFF) + j * 64 + v0; const LAS float* o1 = o0 + 4096;
          float o[8], s = 0.f;
#pragma unroll
          for (int e = 0; e < 8; ++e) { o[e] = o0[e] + o1[e]; s += o[e] * o[e]; }
          s += shx(s, 1, lane); s += shx(s, 2, lane); s += shx(s, 4, lane);
          const float rinv = __builtin_amdgcn_rsqf(s * (1.f / 64.f) + RMS_EPS);
          const size_t gi = (r0 + j) * 512 + hh * 64 + v0; float gt[8]; unpack8(graw_cur, gt);
#pragma unroll
          for (int e = 0; e < 8; ++e) o[e] = o[e] * rinv * norm_g[v0 + e] * fsilu(gt[e]);
          *(u32x4*)(YH + gi) = pack8(o); }
        __syncthreads();
    }
}
__device__ __forceinline__ void carry(float* ST, const float* DEC, int G, int tid) {
    for (int u = blockIdx.x; u < 512; u += G) {
        const int chain = u >> 3, idx = (u & 7) * 512 + tid, kdec = idx & 63, d = chain & 1;
        float* sp = ST + (size_t)chain * NCH * 4096 + idx; const float* dp = DEC + (size_t)chain * NCH * 64 + kdec;
        float S = 0.f;
        for (int s0 = 0; s0 < NCH; s0 += 12) { float dl[12], dc[12]; int cc[12];
#pragma unroll
            for (int q = 0; q < 12; ++q) { const int s = s0 + q; cc[q] = d ? (s < 4 ? 3 - s : 135 - s) : s; dl[q] = sp[(size_t)cc[q] * 4096]; dc[q] = dp[cc[q] * 64]; }
#pragma unroll
            for (int q = 0; q < 12; ++q) { sp[(size_t)cc[q] * 4096] = S; S = dc[q] * S + dl[q]; } }
    }
}
}

__device__ __forceinline__ void s5_carry(const float* E, bf16* AG, const float* POW, int l, int gtid, int NT) {
    for (int i = gtid; i < NB * 16 * 2 * 64; i += NT) {
        const int p = i & 63, d = (i >> 6) & 1, g = (i >> 7) & 15, b = i >> 11;
        const size_t pi = ((((size_t)(l * 2 + d) * 16 + g) * 64 + p) * 65 + 64) * 2; const float lr = POW[pi], li = POW[pi + 1];
        float hr = 0.f, hi = 0.f;
        static_assert(NCH % 44 == 0, "three batches of 44 loads in flight: the chain is latency-bound");
        for (int s0 = 0; s0 < NCH; s0 += 44) { f32x2 ev[44];
#pragma unroll
            for (int q = 0; q < 44; ++q) { const int s = s0 + q; const int cq = d ? (s < 4 ? 3 - s : 135 - s) : s; ev[q] = *(const f32x2*)(E + ((size_t)(g * NCHT + b * NCH + cq)) * 256 + d * 128 + 2 * p); }
#pragma unroll
            for (int q = 0; q < 44; ++q) { const int s = s0 + q; const int cq = d ? (s < 4 ? 3 - s : 135 - s) : s; *(unsigned*)(AG + ((size_t)(g * SROWS + b * NCH + cq)) * SLD + 1024 + d * 128 + 2 * p) = cvt_pk_bf16(hr, hi);
                const float nr = lr * hr - li * hi + ev[q].x, ni = lr * hi + li * hr + ev[q].y; hr = nr; hi = ni; } }
    }
}

__device__ __forceinline__ void moe_route(const float* RT, const float* bE, const float* bG, bool skip_ctx, int* asg_gid, int* asg_pos, float* asg_w, unsigned* gcnt, LAS unsigned char* lds, int G, int tid) {
    LAS unsigned* lcnt = (LAS unsigned*)lds; LAS unsigned* lbase = lcnt + 64;
    for (int base = blockIdx.x * 512; base < R; base += G * 512) {
        if (tid < 64) lcnt[tid] = 0u;
        __syncthreads();
        const int row = base + tid; const int bb = row / RB; const bool valid = !(skip_ctx && (row - bb * RB) < CTX);
        int gid0 = -1, gid1 = -1; unsigned rk0 = 0u, rk1 = 0u; float w0 = 0.f, w1 = 0.f;
        if (valid) {
            const float* lr = RT + (size_t)row * 64;
            const f32x4 lgv = *(const f32x4*)(lr + 32); const float lg[4] = {lgv[0] + bG[0], lgv[1] + bG[1], lgv[2] + bG[2], lgv[3] + bG[3]};
            int gs = 0; float gm = lg[0];
#pragma unroll
            for (int q = 1; q < 4; ++q) if (lg[q] > gm) { gm = lg[q]; gs = q; }
            float zs = 0.f;
#pragma unroll
            for (int q = 0; q < 4; ++q) zs += __expf(lg[q] - gm);
            const float pg = 1.f / zs;
            const f32x4 ea = *(const f32x4*)(lr + gs * 8), eb = *(const f32x4*)(lr + gs * 8 + 4);
            float le[8] = {ea[0], ea[1], ea[2], ea[3], eb[0], eb[1], eb[2], eb[3]};
#pragma unroll
            for (int q = 0; q < 8; ++q) le[q] += bE[gs * 8 + q];
            int i0 = 0; float m0 = le[0];
#pragma unroll
            for (int q = 1; q < 8; ++q) if (le[q] > m0) { m0 = le[q]; i0 = q; }
            int i1 = -1; float m1 = -3.0e38f;
#pragma unroll
            for (int q = 0; q < 8; ++q) if (q != i0 && le[q] > m1) { m1 = le[q]; i1 = q; }
            const float e1 = __expf(m1 - m0); w0 = pg / (1.f + e1); w1 = pg * e1 / (1.f + e1);
            gid0 = gs * 8 + i0; gid1 = 32 + gs * 8 + i1;
            rk0 = __hip_atomic_fetch_add(&lcnt[gid0], 1u, __ATOMIC_RELAXED, __HIP_MEMORY_SCOPE_WORKGROUP);
            rk1 = __hip_atomic_fetch_add(&lcnt[gid1], 1u, __ATOMIC_RELAXED, __HIP_MEMORY_SCOPE_WORKGROUP);
        }
        __syncthreads();
        if (tid < 64) { const unsigned n = lcnt[tid]; lbase[tid] = n ? __hip_atomic_fetch_add(&gcnt[tid], n, __ATOMIC_RELAXED, __HIP_MEMORY_SCOPE_AGENT) : 0u; }
        __syncthreads();
        asg_gid[row * 2] = gid0; asg_gid[row * 2 + 1] = gid1;
        if (valid) { asg_pos[row * 2] = (int)(lbase[gid0] + rk0); asg_pos[row * 2 + 1] = (int)(lbase[gid1] + rk1); asg_w[row * 2] = w0; asg_w[row * 2 + 1] = w1; }
        __syncthreads();
    }
}
__device__ __forceinline__ void moe_scatter(const unsigned* gcnt, const int* asg_gid, const int* asg_pos, const float* asg_w, int* slot_row, float* slot_w, int* tile_tab, const bf16* HX, bf16* XG,
                                            LAS unsigned char* lds, int gw, int NGW, int tid, int lane) {
    LAS int* tstart = (LAS int*)lds;
    if (tid == 0) { int acc = 0;
        for (int g = 0; g < 64; ++g) { if (g == 32) tstart[64] = acc; tstart[g] = acc; acc += ((int)gcnt[g] + 255) >> 8; }
        tstart[65] = acc; }
    __syncthreads();
    if (blockIdx.x == 0) {
        if (tid < 64) { const int t0 = tstart[tid], t1 = (tid == 63) ? tstart[65] : tstart[tid + 1]; for (int t = t0; t < t1; ++t) tile_tab[t] = tid & 31; }
        if (tid == 0) { tile_tab[1024] = tstart[64]; tile_tab[1025] = tstart[65]; }
    }
    for (int a = gw * 64 + lane; a < 2 * R; a += NGW * 64) {
        const int gid = asg_gid[a]; if (gid < 0) continue;
        const int slot = tstart[gid] * 256 + asg_pos[a]; slot_row[slot] = a >> 1; slot_w[slot] = asg_w[a]; }
}

__device__ __forceinline__ int hg_next_unit(int u, int vcu, int bx, int G, int SKIP, int FULL) { const int cut = FULL * G; if (u < cut) { const int v = u + G; if (v < cut) return v; return bx >= SKIP ? cut + (bx - SKIP) : (1 << 30); } return u + (G - SKIP); }
constexpr int NPL = 16, NPHASE = 1 + 2 * NPL;
struct Args { Ins in; float* out; unsigned char* ws; int ph_lo, ph_hi; };
#define GEMM_CALL(EpiT, SchedT, g, S, E) pg8::gemm_phase<EpiT, SchedT, true, true>((PG8_LAS unsigned char*)lds, g, S, E, wv)
#ifndef COMP_MASK
#define COMP_MASK 0xFFFFFFFFu
#endif
#ifndef REP_MASK
#define REP_MASK 0u
#endif
#define C(n) ((COMP_MASK >> (n)) & 1u)
#define REPEAT(n) for (int rep_ = 0; rep_ <= (int)((REP_MASK >> (n)) & 1u); ++rep_)

typedef const __attribute__((address_space(4))) Args* KArgs;
__device__ __forceinline__ KArgs kargs() { KArgs p = (KArgs)__builtin_amdgcn_kernarg_segment_ptr(); asm volatile("" : "+s"(p)); return p; }

__global__ void __launch_bounds__(512, 2) hdt_fwd(Args args) {
    extern __shared__ __attribute__((aligned(16))) unsigned char lds_raw[];
    LAS unsigned char* lds = (LAS unsigned char*)lds_raw;
    volatile LAS unsigned* MISC = (volatile LAS unsigned*)(lds + MISC_OFF);
    const int wv = __builtin_amdgcn_readfirstlane((int)threadIdx.x >> 6);
#define ENV KArgs a_ = kargs(); unsigned char* const ws = a_->ws; InsK in = a_->in; float* const out = a_->out; const int G = gridDim.x, bx = blockIdx.x, vcu = (G % 8 == 0) ? (bx % 8) * (G / 8) + bx / 8 : bx; (void)in; (void)out; (void)vcu;
#define TID (wv * 64 + lane_id())
#define LANE (lane_id())
#define WAVE (wv)
#define GW (vcu * 8 + WAVE)
#define NGW (G * 8)
#define GTID (bx * 512 + TID)
#define NTH (G * 512)
    unsigned* ctl = (unsigned*)(args.ws + WS_CTL);
    for (int u = (int)threadIdx.x; u < (LDS_BYTES - RING_BYTES) / 4; u += 512) ((LAS unsigned*)(lds + RING_BYTES))[u] = 0u;
    __syncthreads();
    XcdBarrier bar = xcd_barrier_post(ctl + CW_BAR, MISC + 8, wv);
    const int lo = args.ph_lo, hi = args.ph_hi;
#define CTL ((unsigned*)(ws + WS_CTL))
#define IN(p) (lo <= (p) && (p) < hi)
#ifndef BAR_REP
#define BAR_REP 1
#endif
#define SEAM(p) do { if (lo <= (p) && (p) + 1 < hi) { for (int br_ = 0; br_ < BAR_REP; ++br_) xcd_barrier(bar, wv); } } while (0)
#define W_(off) (ws + (off))
    if (IN(0)) { ENV if (C(23)) REPEAT(23) { mod_vectors(in, (float*)W_(WS_MOD), lds, G, TID, WAVE, LANE); small_tables(in, ws, GTID, NTH); } }
    SEAM(0);

    for (int l = 0; l < 2; ++l) {
        const int P = 1 + l * NPL;
#define MODL ((const float*)W_(WS_MOD) + (size_t)l * 9 * 6144)
#define XIN_LAT (l ? (const void*)W_(WS_XS) : (const void*)in.p[I_X])
#define Y_(off) ((unsigned char*)out + (off))
#define XIN_CTX (l ? (const float*)W_(WS_CTXS) : in.p[I_CTX])
#define H5P ((bf16*)W_(WS_RA + OFF_H5))
        if (IN(P + 0)) { ENV if (C(0)) REPEAT(0) { convert_weights(in, ws, l, lds, GW, NGW, WAVE, LANE); __syncthreads();
            { int nl_ = lane_id(); asm volatile("" : "+v"(nl_)); norm_mix(XIN_LAT, l, XIN_CTX, in.p[I_NMIX] + l * DM, MODL, (unsigned char*)W_(WS_HX), lds, vcu, G, wv, wv * 64 + nl_, nl_); } __syncthreads();
            s5_compact(in, ws, l, lds, G, TID); } }
        SEAM(P + 0);
        if (IN(P + 1)) { ENV if (C(1)) REPEAT(1) s5_expand(in, ws, l, GTID, NTH);
            if (C(2)) REPEAT(2) { pg8::Gemm g{(const bf16*)W_(WS_HX), (const bf16*)W_(WS_WIN), R, 2560, 512, 512, 512};     pg8::StaticOrder S; S.init(R, 2560, G, bx);
                EpiInproj E{(bf16*)W_(WS_RA + OFF_Q), (bf16*)W_(WS_RA + OFF_K), H5P, (bf16*)Y_(0), in.p[I_KG] + l * 64, (const float*)W_(WS_ROPE)}; GEMM_CALL(EpiInproj, pg8::StaticOrder, g, S, E);
                pg8::Gemm g2{(const bf16*)W_(WS_WIN) + (size_t)2560 * 512, (const bf16*)W_(WS_HX), 512, R, 512, 512, 512}; pg8::StaticOrder S2; S2.init(512, R, G, (bx + G - (2640 % G)) % G);
                EpiVT E2{(unsigned char*)W_(WS_RA + OFF_V)}; GEMM_CALL(EpiVT, pg8::StaticOrder, g2, S2, E2); } }
        SEAM(P + 1);
        if (IN(P + 2)) { ENV
            if (C(4)) REPEAT(4) { pg8::Gemm g{(const bf16*)Y_(0), (const bf16*)W_(WS_WE), 16 * SROWS, 16 * 256, 1024, SLD, 1024}; S5Order S; S.init(1, G, bx); EpiS5E E{(float*)W_(WS_E)}; GEMM_CALL(EpiS5E, S5Order, g, S, E); }
            if (C(5)) REPEAT(5) { int hl_ = lane_id(); asm volatile("" : "+v"(hl_)); const int NU_ = NB * NCH * 4; hg::Raw raw_;
                const hg::Ptrs hp_{H5P, H5P + (size_t)R * 256, H5P + (size_t)2 * R * 256, H5P + (size_t)3 * R * 256, H5P + (size_t)4 * R * 256};
                { const int hh = vcu & 3, cb = vcu >> 2, b = cb / NCH, c = cb - b * NCH; hg::load_unit<0>(raw_, b, c, hh, hp_, (const float*)W_(WS_RB), wv, hl_); }
                for (int u = vcu; u < NU_; u = hg_next_unit(u, vcu, bx, G, 80, 12)) { const int hh = u & 3, cb = u >> 2, b = cb / NCH, c = cb - b * NCH; const int un = hg_next_unit(u, vcu, bx, G, 80, 12); const bool hn = un < NU_; const int nhh = un & 3, ncb = un >> 2, nb = ncb / NCH, nc = ncb - nb * NCH;
                    hg::unit<0>(raw_, b, c, hh, hn, nb, nc, nhh, hp_, (const float*)W_(WS_MISC) + l * 512, in.p[I_HGN] + l * 64, (float*)W_(WS_RB), (float*)W_(WS_DEC), (bf16*)Y_(OFF_YS) + 256, lds, wv, hl_); } } }
        SEAM(P + 2);
        if (IN(P + 3)) { ENV if (C(6)) { if (wv == 0) s5_carry((const float*)W_(WS_E), (bf16*)Y_(0), (const float*)W_(WS_POW), l, vcu * 64 + LANE, G * 64);     hg::carry((float*)W_(WS_RB), (const float*)W_(WS_DEC), G, TID); } }
        SEAM(P + 3);
        if (IN(P + 4)) { ENV
            if (C(7)) REPEAT(7) { pg8::Gemm g{(const bf16*)Y_(0), (const bf16*)W_(WS_WTOT), 16 * SROWS, 16 * 1024, SLD, SLD, SLD}; S5Order S; S.init(4, G, bx);
                EpiS5Out E{(const bf16*)Y_(0), in.p[I_S5D] + l * 256, (bf16*)Y_(OFF_YS)}; GEMM_CALL(EpiS5Out, S5Order, g, S, E); }
            if (C(8)) REPEAT(8) { int hl_ = lane_id(); asm volatile("" : "+v"(hl_)); const int NU_ = NB * NCH * 4; hg::Raw raw_;
                const hg::Ptrs hp_{H5P, H5P + (size_t)R * 256, H5P + (size_t)2 * R * 256, H5P + (size_t)3 * R * 256, H5P + (size_t)4 * R * 256};
                { const int hh = vcu & 3, cb = vcu >> 2, b = cb / NCH, c = cb - b * NCH; hg::load_unit<1>(raw_, b, c, hh, hp_, (const float*)W_(WS_RB), wv, hl_); }
                for (int u = vcu; u < NU_; u = hg_next_unit(u, vcu, bx, G, 64, 13)) { const int hh = u & 3, cb = u >> 2, b = cb / NCH, c = cb - b * NCH; const int un = hg_next_unit(u, vcu, bx, G, 64, 13); const bool hn = un < NU_; const int nhh = un & 3, ncb = un >> 2, nb = ncb / NCH, nc = ncb - nb * NCH;
                    hg::unit<1>(raw_, b, c, hh, hn, nb, nc, nhh, hp_, (const float*)W_(WS_MISC) + l * 512, in.p[I_HGN] + l * 64, (float*)W_(WS_RB), (float*)W_(WS_DEC), (bf16*)Y_(OFF_YS) + 256, lds, wv, hl_); } } }
        SEAM(P + 4);
        if (IN(P + 5)) { ENV
            if (C(9)) { pg8::Gemm g{(const bf16*)Y_(OFF_YS), (const bf16*)W_(WS_WGLU), R, 256, 256, 512, 256}; RowOrder S; S.init(256, G, bx, l == 1);
                EpiGlu E{(bf16*)Y_(OFF_YS), in.p[I_GLUB] + l * 256}; GEMM_CALL(EpiGlu, RowOrder, g, S, E); }
            if (C(10)) REPEAT(10) { const float lam = ((const float*)W_(WS_MISC))[1024 + l], oscale = 1.f - ((const float*)W_(WS_MISC))[1026 + l];
                const int nu = 2048 + (l == 0 ? 64 : 0);
                for (int u = vcu; u < nu; u += G) {
                    int b, h, qrow0, seq;
                    if (u < 2048) { const int bh = u >> 6, qb = u & 63; b = bh >> 2; h = bh & 3; qrow0 = CTX + qb * 128; seq = RB; }
                    else { const int v = u - 2048; b = v >> 3; h = (v >> 1) & 3; qrow0 = (v & 1) * 128; seq = CTX; }
                    const size_t rb = (size_t)b * RB;
                    att::diff_attn_unit((const bf16*)W_(WS_RA + OFF_Q) + (rb + qrow0) * 512 + h * 128, (const unsigned char*)W_(WS_RA + OFF_K) + rb * 512 + h * 128, (const unsigned char*)W_(WS_RA + OFF_V) + ((size_t)b * 512 + h * 128) * RB,
                                        (bf16*)Y_(0) + (rb + qrow0) * 512 + h * 128, seq, lam, oscale, in.p[I_SUBLN] + l * 128, in.p[I_QG] + l * 64, (const float*)W_(WS_ROPE), (u < 2048) ? (qrow0 - CTX) : -1, (LAS char*)lds, wv);
                } } }
        SEAM(P + 5);
        if (IN(P + 6)) { ENV if (C(11)) REPEAT(11) { pg8::Gemm g{(const bf16*)W_(WS_HX), (const bf16*)W_(WS_WIN) + (size_t)3072 * 512, R, 3072, 512, 512, 512}; RowOrder S; S.init(3072, G, bx, l == 1);
            EpiGates E{(unsigned char*)W_(WS_RA)}; GEMM_CALL(EpiGates, RowOrder, g, S, E); } }
        SEAM(P + 6);
        if (IN(P + 7)) { ENV if (C(12)) REPEAT(12) { RowOrder S; S.init(1024, G, bx, l == 1);
            pg8::Gemm g{(const bf16*)Y_(0), (const bf16*)W_(WS_WOA), R, 1024, 1024, 512, 1024, (const bf16*)Y_(OFF_YS), 8, 12};
            EpiMerge E{(const unsigned char*)W_(WS_RA), (bf16*)W_(WS_RB)}; GEMM_CALL(EpiMerge, RowOrder, g, S, E); } }
        SEAM(P + 7);
        if (IN(P + 8)) { ENV if (C(15)) for (int rep_ = 0; rep_ <= (int)(((REP_MASK >> 15) & 1u) && l == 0); ++rep_) { pg8::Gemm g{(const bf16*)W_(WS_RB), (const bf16*)W_(WS_WOUT), R, 1024, 1024, 1024, 1024}; RowOrder S; S.init(1024, G, bx, l == 1);
            EpiWout E{XIN_LAT, XIN_CTX, (bf16*)W_(WS_XS), (float*)W_(WS_CTXS), MODL, l}; GEMM_CALL(EpiWout, RowOrder, g, S, E); } }
        SEAM(P + 8);
#define ASG_GID ((int*)W_(WS_ASG))
#define ASG_POS (ASG_GID + 2 * R)
#define ASG_W ((float*)(ASG_POS + 2 * R))
        if (IN(P + 9)) { ENV if (C(16)) REPEAT(16) { { int nl_ = lane_id(); asm volatile("" : "+v"(nl_)); norm_route((const bf16*)W_(WS_XS), (const float*)W_(WS_CTXS), in.p[I_NFFN] + l * DM, MODL, (bf16*)W_(WS_HX), (const bf16*)W_(WS_WRT), in.p[I_MBE] + l * 32, in.p[I_MBG] + l * 4, ASG_GID, ASG_POS, ASG_W, CTL + CW_GCNT + l * 64, lds, l == 1, vcu, G, wv, wv * 64 + nl_, nl_); } for (int i = GTID; i < NSLOT; i += NTH) ((int*)W_(WS_SLOT))[i] = -1; } }
        SEAM(P + 9);
#define SLOT_ROW ((int*)W_(WS_SLOT))
#define SLOT_W ((float*)(SLOT_ROW + NSLOT))
#define TILE_TAB ((int*)W_(WS_TILE))
        if (IN(P + 12)) { ENV if (C(19)) REPEAT(19) moe_scatter(CTL + CW_GCNT + l * 64, ASG_GID, ASG_POS, ASG_W, SLOT_ROW, SLOT_W, TILE_TAB, (const bf16*)W_(WS_HX), (bf16*)W_(WS_RA), lds, GW, NGW, TID, LANE); }
        SEAM(P + 12);
        if (IN(P + 13)) { ENV if (C(20)) REPEAT(20) { const int nt = TILE_TAB[1025]; pg8::Gemm g{(const bf16*)W_(WS_HX), (const bf16*)W_(WS_WGU), nt * 256, 1024, 1024, 1024, 1024}; MoeOrderT<true> S; S.init(TILE_TAB, SLOT_ROW, 0, nt, G, bx);
            EpiMoe1 E{(bf16*)W_(WS_RB)}; GEMM_CALL(EpiMoe1, MoeOrderT<true>, g, S, E); } }
        SEAM(P + 13);
        if (IN(P + 14)) { ENV if (C(21)) REPEAT(21) { const int nt0 = TILE_TAB[1024]; pg8::Gemm g{(const bf16*)W_(WS_RB), (const bf16*)W_(WS_WDN), nt0 * 256, 1024, 512, 512, 512}; MoeOrderT<false> S; S.init(TILE_TAB, SLOT_ROW, 0, nt0, G, bx);
            EpiMoe2<0> E{SLOT_ROW, SLOT_W, (bf16*)W_(WS_XS), out, (float*)W_(WS_CTXS), MODL, (bf16*)W_(WS_RA), 1.f, l}; GEMM_CALL(EpiMoe2<0>, MoeOrderT<false>, g, S, E); } }
        SEAM(P + 14);
        if (IN(P + 15)) { ENV if (C(22)) { const int nt0 = TILE_TAB[1024], nt = TILE_TAB[1025]; pg8::Gemm g{(const bf16*)W_(WS_RB), (const bf16*)W_(WS_WDN), nt * 256, 1024, 512, 512, 512}; MoeOrderT<false> S; S.init(TILE_TAB, SLOT_ROW, nt0, nt - nt0, G, bx);
            EpiMoe2<1> E{SLOT_ROW, SLOT_W, (bf16*)W_(WS_XS), out, (float*)W_(WS_CTXS), MODL, (bf16*)W_(WS_RA), 1.f, l}; GEMM_CALL(EpiMoe2<1>, MoeOrderT<false>, g, S, E); } }
        SEAM(P + 15);
    }
#undef IN
#undef SEAM
}


#ifdef DBG_DUMP_OFF
__global__ void dbg_dump(const unsigned char* ws, float* out, size_t n) {
    for (size_t i = (size_t)blockIdx.x * 256 + threadIdx.x; i < n; i += (size_t)gridDim.x * 256) {
#if DBG_DUMP_F32
        out[i] = ((const float*)(ws + DBG_DUMP_OFF))[i];
#else
        out[i] = bf2f(((const bf16*)(ws + DBG_DUMP_OFF))[i]);
#endif
    }
}
#endif

#ifndef DBG_LAYER
#define DBG_LAYER 0
#endif
#ifndef DBG_LAST
#define DBG_LAST NPHASE
#endif
#ifndef MK_MULTI
#define MK_MULTI 0
#endif
extern "C" void kernel_launch(void* const* d_in, const int* in_sizes, int n_in, void* d_out, int out_size, void* d_ws, size_t ws_size, hipStream_t stream) {
    static int grid = 0;
    if (grid == 0) {
        if (n_in != 36 || out_size != NB * SEQ * DM || ws_size < WS_END) { fprintf(stderr, "kernel_launch: unexpected shapes (n_in %d out %d ws %zu, need ws >= %zu)\n", n_in, out_size, ws_size, (size_t)WS_END); grid = -1; return; }
        int dev = 0, cus = 0, per_cu = 0;
        if (hipGetDevice(&dev) != hipSuccess || hipDeviceGetAttribute(&cus, hipDeviceAttributeMultiprocessorCount, dev) != hipSuccess) { grid = -1; return; }
        if (hipFuncSetAttribute((const void*)hdt_fwd, hipFuncAttributeMaxDynamicSharedMemorySize, LDS_BYTES) != hipSuccess) { fprintf(stderr, "kernel_launch: hipFuncSetAttribute failed\n"); grid = -1; return; }
        if (hipOccupancyMaxActiveBlocksPerMultiprocessor(&per_cu, (const void*)hdt_fwd, 512, LDS_BYTES) != hipSuccess || per_cu < 1) fprintf(stderr, "kernel_launch: occupancy query reports %d\n", per_cu);
        (void)hipGetLastError();
        grid = cus;
    }
    if (grid < 0) return;
    if (hipMemsetAsync((char*)d_ws + WS_CTL, 0, CTL_BYTES, stream) != hipSuccess) return;
    Args a{};
    for (int i = 0; i < 36; ++i) a.in.p[i] = (const float*)d_in[i];
    a.out = (float*)d_out; a.ws = (unsigned char*)d_ws;
#if MK_MULTI
    for (int p = 0; p < DBG_LAST; ++p) { a.ph_lo = p; a.ph_hi = p + 1; hipLaunchKernelGGL(hdt_fwd, dim3(grid), dim3(512), LDS_BYTES, stream, a);
    }
#else
    a.ph_lo = 0; a.ph_hi = NPHASE; hipLaunchKernelGGL(hdt_fwd, dim3(grid), dim3(512), LDS_BYTES, stream, a);
#endif
#ifdef DBG_COPY_X
    (void)hipMemcpyAsync(d_out, d_in[0], (size_t)NB * SEQ * DM * 4, hipMemcpyDeviceToDevice, stream);
#endif
#ifdef DBG_DUMP_OFF
    hipLaunchKernelGGL(dbg_dump, dim3(2048), dim3(256), 0, stream, (const unsigned char*)d_ws, (float*)d_out, (size_t)NB * SEQ * DM);
#endif
    const hipError_t le = hipPeekAtLastError();
    if (le != hipSuccess) fprintf(stderr, "kernel_launch: launch failed: %s\n", hipGetErrorName(le));
}
```
